# Optimizing an MI355X kernel written in HIP

```python
import math
import jax
import jax.numpy as jnp
from jax import lax
import numpy as np


D_MODEL = 4096
BATCH = 4
SEQ = 2048
DEPTH = 2

MEM_LEN = 256
MLA_HEADS = 16
MLA_NOPE = 128
MLA_ROPE = 64
MLA_V = 128
MLA_Q_RANK = 1024
MLA_KV_RANK = 512
SB_HEADS = 16
SB_DIM = 128
X_HEADS = 4
X_DIM = 128
FFN_HIDDEN = -(-(8 * D_MODEL) // (3 * 256)) * 256
Q_BLOCK = 128
ROPE_THETA = 10000.0
EPS = 1e-6
MLA_QK = MLA_NOPE + MLA_ROPE
SB_WIDTH = SB_HEADS * SB_DIM
MLA_WIDTH = MLA_HEADS * MLA_V
MIX_WIDTH = MLA_WIDTH + SB_WIDTH
IN_COLS = MLA_Q_RANK + MLA_KV_RANK + MLA_ROPE + 3 * SB_WIDTH

kernel_name = "hymba_mla_stickbreaking_hybrid"


def rmsnorm(x, g):
    xf = x.astype(jnp.float32)
    y = xf * lax.rsqrt(jnp.mean(xf * xf, axis=-1, keepdims=True) + EPS)
    return (y * g.astype(jnp.float32)).astype(x.dtype)


def rope(x, positions):
    half = x.shape[-1] // 2
    inv_freq = ROPE_THETA ** (-jnp.arange(half, dtype=jnp.float32) / half)
    ang = positions.astype(jnp.float32)[..., None] * inv_freq
    ang = ang.reshape(ang.shape[:2] + (1,) * (x.ndim - 3) + (half,))
    cos, sin = jnp.cos(ang), jnp.sin(ang)
    xf = x.astype(jnp.float32)
    x1, x2 = xf[..., :half], xf[..., half:]
    return jnp.concatenate([x1 * cos - x2 * sin, x1 * sin + x2 * cos], axis=-1).astype(x.dtype)


def mla_attention(cq, ckv, k_rope, positions, w_q_up, w_kv_up, g_q_lat, g_kv_lat, g_q, g_k):
    B, S = cq.shape[:2]
    q = (rmsnorm(cq, g_q_lat) @ w_q_up).reshape(B, S, MLA_HEADS, MLA_QK)
    kv = (rmsnorm(ckv, g_kv_lat) @ w_kv_up).reshape(B, S, MLA_HEADS, MLA_NOPE + MLA_V)
    k_nope, v = kv[..., :MLA_NOPE], kv[..., MLA_NOPE:]
    q_nope = rmsnorm(q[..., :MLA_NOPE], g_q[:MLA_NOPE])
    q_rope = rope(rmsnorm(q[..., MLA_NOPE:], g_q[MLA_NOPE:]), positions)
    k_nope = rmsnorm(k_nope, g_k[:MLA_NOPE])
    k_rope = rope(rmsnorm(k_rope, g_k[MLA_NOPE:]), positions)
    scale = 1.0 / math.sqrt(MLA_QK)
    outs = []
    for i in range(S // Q_BLOCK):
        lo, hi = i * Q_BLOCK, (i + 1) * Q_BLOCK
        s = (jnp.einsum('bqhd,bkhd->bhqk', q_nope[:, lo:hi], k_nope[:, :hi])
             + jnp.einsum('bqhr,bkr->bhqk', q_rope[:, lo:hi], k_rope[:, :hi])).astype(jnp.float32) * scale
        causal = jnp.arange(hi)[None, :] <= (lo + jnp.arange(Q_BLOCK))[:, None]
        p = jax.nn.softmax(jnp.where(causal, s, -jnp.inf), axis=-1)
        outs.append(jnp.einsum('bhqk,bkhd->bqhd', p.astype(v.dtype), v[:, :hi]))
    return jnp.concatenate(outs, axis=1).reshape(B, S, MLA_WIDTH)


def stick_breaking_attention(q, k, v):
    B, S = q.shape[:2]
    scale = 1.0 / math.sqrt(SB_DIM)
    outs = []
    for i in range(S // Q_BLOCK):
        lo, hi = i * Q_BLOCK, (i + 1) * Q_BLOCK
        z = jnp.einsum('bqhd,bkhd->bhqk', q[:, lo:hi], k[:, :hi]).astype(jnp.float32) * scale
        strict = jnp.arange(hi)[None, :] < (lo + jnp.arange(Q_BLOCK))[:, None]
        log_beta = jax.nn.log_sigmoid(z)
        log_keep = jnp.where(strict, jax.nn.log_sigmoid(-z), 0.0)
        log_rest = lax.cumsum(log_keep, axis=3, reverse=True) - log_keep
        a = jnp.where(strict, jnp.exp(log_beta + log_rest), 0.0)
        outs.append(jnp.einsum('bhqk,bkhd->bqhd', a.astype(v.dtype), v[:, :hi]))
    return jnp.concatenate(outs, axis=1).reshape(B, S, SB_WIDTH)


def memory_cross_attention(h, mem, w_xq, w_xkv, g_mem, g_xq, g_xk, w_xo):
    B, S = h.shape[:2]
    M = mem.shape[1]
    q = rmsnorm((h @ w_xq).reshape(B, S, X_HEADS, X_DIM), g_xq)
    kv = (rmsnorm(mem, g_mem) @ w_xkv).reshape(B, M, X_HEADS, 2 * X_DIM)
    k = rmsnorm(kv[..., :X_DIM], g_xk)
    v = kv[..., X_DIM:]
    s = jnp.einsum('bqhd,bmhd->bhqm', q, k).astype(jnp.float32) * (1.0 / math.sqrt(X_DIM))
    p = jax.nn.softmax(s, axis=-1)
    o = jnp.einsum('bhqm,bmhd->bqhd', p.astype(v.dtype), v).reshape(B, S, X_HEADS * X_DIM)
    return o @ w_xo


def _w(k, shape, fan_in):
    return jax.random.normal(k, shape, jnp.float32) * (fan_in ** -0.5)


def _g(k, shape):
    return 1.0 + 0.02 * jax.random.normal(k, shape, jnp.float32)


def setup_inputs(seed: int = 0) -> dict:
    key = jax.random.key(seed)
    ks = jax.random.split(key, 26)
    L = DEPTH
    x = jax.random.normal(ks[0], (BATCH, SEQ, D_MODEL), jnp.float32)
    mem = jax.random.normal(ks[1], (BATCH, MEM_LEN, D_MODEL), jnp.float32)
    offsets = jax.random.randint(ks[2], (BATCH, 1), 0, 1024, dtype=jnp.int32)
    positions = (jnp.arange(SEQ, dtype=jnp.int32)[None, :] + offsets).astype(jnp.int32)
    return {
        "x": x,
        "mem": mem,
        "positions": positions,
        "g_attn": _g(ks[3], (L, D_MODEL)),
        "w_in": _w(ks[4], (L, D_MODEL, IN_COLS), D_MODEL),
        "g_q_lat": _g(ks[5], (L, MLA_Q_RANK)),
        "g_kv_lat": _g(ks[6], (L, MLA_KV_RANK)),
        "w_q_up": _w(ks[7], (L, MLA_Q_RANK, MLA_HEADS * MLA_QK), MLA_Q_RANK),
        "w_kv_up": _w(ks[8], (L, MLA_KV_RANK, MLA_HEADS * (MLA_NOPE + MLA_V)), MLA_KV_RANK),
        "g_mla_q": _g(ks[9], (L, MLA_QK)),
        "g_mla_k": _g(ks[10], (L, MLA_QK)),
        "g_mla_out": _g(ks[11], (L, MLA_WIDTH)),
        "g_sb_out": _g(ks[12], (L, SB_WIDTH)),
        "w_out": _w(ks[13], (L, MIX_WIDTH, D_MODEL), MIX_WIDTH),
        "g_cross": _g(ks[14], (L, D_MODEL)),
        "g_mem": _g(ks[15], (L, D_MODEL)),
        "w_xq": _w(ks[16], (L, D_MODEL, X_HEADS * X_DIM), D_MODEL),
        "w_xkv": _w(ks[17], (L, D_MODEL, 2 * X_HEADS * X_DIM), D_MODEL),
        "g_xq": _g(ks[18], (L, X_DIM)),
        "g_xk": _g(ks[19], (L, X_DIM)),
        "w_xo": _w(ks[20], (L, X_HEADS * X_DIM, D_MODEL), X_HEADS * X_DIM),
        "g_ffn": _g(ks[21], (L, D_MODEL)),
        "w_gate": _w(ks[22], (L, D_MODEL, FFN_HIDDEN), D_MODEL),
        "w_up": _w(ks[23], (L, D_MODEL, FFN_HIDDEN), D_MODEL),
        "w_down": _w(ks[24], (L, FFN_HIDDEN, D_MODEL), FFN_HIDDEN),
    }


def reference(x, mem, positions, g_attn, w_in, g_q_lat, g_kv_lat, w_q_up, w_kv_up,
              g_mla_q, g_mla_k, g_mla_out, g_sb_out, w_out, g_cross, g_mem, w_xq, w_xkv,
              g_xq, g_xk, w_xo, g_ffn, w_gate, w_up, w_down):
    B, S = x.shape[:2]
    splits = np.cumsum([MLA_Q_RANK, MLA_KV_RANK, MLA_ROPE, SB_WIDTH, SB_WIDTH]).tolist()
    for l in range(DEPTH):
        n = rmsnorm(x, g_attn[l])
        proj = n @ w_in[l]
        cq, ckv, k_rope, q_sb, k_sb, v_sb = jnp.split(proj, splits, axis=-1)
        o_mla = mla_attention(cq, ckv, k_rope, positions, w_q_up[l], w_kv_up[l],
                              g_q_lat[l], g_kv_lat[l], g_mla_q[l], g_mla_k[l])
        o_sb = stick_breaking_attention(q_sb.reshape(B, S, SB_HEADS, SB_DIM),
                                        k_sb.reshape(B, S, SB_HEADS, SB_DIM),
                                        v_sb.reshape(B, S, SB_HEADS, SB_DIM))
        mixed = jnp.concatenate([rmsnorm(o_mla, g_mla_out[l]), rmsnorm(o_sb, g_sb_out[l])], axis=-1)
        x = x + mixed @ w_out[l]
        x = x + memory_cross_attention(rmsnorm(x, g_cross[l]), mem, w_xq[l], w_xkv[l],
                                       g_mem[l], g_xq[l], g_xk[l], w_xo[l])
        h = rmsnorm(x, g_ffn[l])
        x = x + (jax.nn.silu(h @ w_gate[l]) * (h @ w_up[l])) @ w_down[l]
    return x
```

```cpp
#include <hip/hip_runtime.h>
#include <cstdio>
#include <cstdint>
namespace pg8 {
#define PG8_LAS __attribute__((address_space(3)))
typedef unsigned short bf16_t;
typedef short bf16x8 __attribute__((ext_vector_type(8)));
typedef float f32x4 __attribute__((ext_vector_type(4)));
typedef unsigned u32x4 __attribute__((ext_vector_type(4)));
constexpr int BM = 256, BK = 64, HALF = 128, HTB = HALF * BK * 2  , STAGE_BYTES = 8 * HTB, NXCD = 8, WGM = 8;

__host__ __device__ __forceinline__ int lds_byte(int r, int c) { const int st = (r >> 4) * 2 + (c >> 5), rr = r & 15, cc = c & 31, ob = rr * 64 + cc * 2; return st * 1024 + (ob ^ (((ob >> 9) & 1) << 5)); }
__host__ __device__ __forceinline__ void stage_rc(int b, int& R, int& C) { const int st = b / 1024, sb = b % 1024, swz = sb ^ (((sb >> 9) & 1) << 5); R = (st >> 1) * 16 + swz / 64; C = (st & 1) * 32 + (swz % 64) / 2; }
__host__ __device__ __forceinline__ int perm32(int rho) { const int n = rho >> 4, i = rho & 15; return 8 * (i >> 2) + 4 * n + (i & 3); }

struct Unit { int pm, pn; };
struct Gemm { const bf16_t* A; const bf16_t* Bt; int M, N, K; };

struct StaticOrder {
    int nM, nN, nwg, G, c;
    __host__ __device__ void init(int M, int N, int G_, int c_) { nM = M / BM; nN = N / BM; nwg = nM * nN; G = G_; c = c_; }
    __host__ __device__ bool next(int i, Unit& u) const {
        const long L = (long)i * G + c; if (L >= nwg) return false;
        int wgid = (int)L; { const int q = nwg / NXCD, r = nwg % NXCD, xcd = wgid % NXCD, off = wgid / NXCD; wgid = (xcd < r ? xcd * (q + 1) : r * (q + 1) + (xcd - r) * q) + off; }
        const int nig = WGM * nN, gid = wgid / nig, fm = gid * WGM, gsz = (nM - fm) < WGM ? (nM - fm) : WGM;
        u.pm = fm + ((wgid % nig) % gsz); u.pn = (wgid % nig) / gsz; return true;
    }
    __device__ __forceinline__ void a_ready(const Unit&) const {}
    __device__ __forceinline__ void done(const Unit&) const {}
};

__device__ __forceinline__ unsigned cvt_pk_bf16(float lo, float hi) { unsigned r; asm volatile("v_cvt_pk_bf16_f32 %0, %1, %2" : "=v"(r) : "v"(lo), "v"(hi)); return r; }
constexpr float RMS_EPS = 1e-6f;
__device__ __forceinline__ float ld_sc1(const float* p) { return __hip_atomic_load(p, __ATOMIC_RELAXED, __HIP_MEMORY_SCOPE_AGENT); }
__device__ __forceinline__ void add_f32(float* p, float v) { (void)__hip_atomic_fetch_add(p, v, __ATOMIC_RELAXED, __HIP_MEMORY_SCOPE_AGENT); }
__device__ __forceinline__ float sq4(const f32x4 v) { return (v[0] * v[0] + v[1] * v[1]) + (v[2] * v[2] + v[3] * v[3]); }
__device__ __forceinline__ u32x4 pack8(const f32x4 a, const f32x4 b) { u32x4 w; w.x = cvt_pk_bf16(a[0], a[1]); w.y = cvt_pk_bf16(a[2], a[3]); w.z = cvt_pk_bf16(b[0], b[1]); w.w = cvt_pk_bf16(b[2], b[3]); return w; }

template <int NS>
__device__ __forceinline__ float row_ssq(const float* part, int row, int fq) {
    float s = 0.f;
    if constexpr (NS >= 16) { constexpr int PER = NS / 4; const f32x4* p = (const f32x4*)(part + (size_t)row * NS + fq * PER);
#pragma unroll
        for (int i = 0; i < PER / 4; ++i) { const f32x4 v = p[i]; s += (v[0] + v[1]) + (v[2] + v[3]); } }
    else { static_assert(NS == 8, "NS"); if (fq < 2) { const f32x4 v = *(const f32x4*)(part + (size_t)row * 8 + fq * 4); s = (v[0] + v[1]) + (v[2] + v[3]); } }
    s += __shfl_xor(s, 16); s += __shfl_xor(s, 32); return s;
}
template <int NS> struct EpiScaleBf16 {
    static constexpr bool PERM = true, AFTER_DRAIN = false;
    const float* ssq; float inv_n; bf16_t* O; int ldc;
    __device__ __forceinline__ void operator()(const f32x4 (&acc)[2][2][4][2], const Unit& u, int wr, int wc, int fr, int fq) const {
        const int row0 = u.pm * BM + wr * 64 + fr, col0 = u.pn * BM + wc * 32 + 8 * fq;
#pragma unroll
        for (int ai = 0; ai < 2; ++ai)
#pragma unroll
            for (int m = 0; m < 4; ++m) { const int row = row0 + ai * HALF + m * 16; const float rinv = rsqrtf(row_ssq<NS>(ssq, row, fq) * inv_n + RMS_EPS);
                bf16_t* rowp = O + (size_t)row * ldc + col0;
#pragma unroll
                for (int bj = 0; bj < 2; ++bj) *(u32x4*)(rowp + bj * HALF) = pack8(acc[ai][bj][m][0] * rinv, acc[ai][bj][m][1] * rinv); }
    }
};

struct EpiInProj {
    static constexpr bool PERM = true, AFTER_DRAIN = false;
    const float* ssq_x; bf16_t *cq, *ckv, *qsb, *ksb, *vsb; float* kr; float *ssq_cq, *ssq_ckv;
    __device__ __forceinline__ void operator()(const f32x4 (&acc)[2][2][4][2], const Unit& u, int wr, int wc, int fr, int fq) const {
        const int pn = u.pn, row0 = u.pm * BM + wr * 64 + fr, cw = wc * 32 + 8 * fq;
        bf16_t* base; int ldc, colt; float* ssq = nullptr; int ns = 0, slot = 0;
        if (pn < 4) { base = cq; ldc = 1024; colt = pn * 256; ssq = ssq_cq; ns = 16; slot = pn * 4 + wc; }
        else if (pn < 6) { base = ckv; ldc = 512; colt = (pn - 4) * 256; ssq = ssq_ckv; ns = 8; slot = (pn - 4) * 4 + wc; }
        else if (pn < 14) { base = qsb; ldc = 2048; colt = (pn - 6) * 256; }
        else if (pn < 22) { base = ksb; ldc = 2048; colt = (pn - 14) * 256; }
        else if (pn < 30) { base = vsb; ldc = 2048; colt = (pn - 22) * 256; }
        else { base = nullptr; ldc = 0; colt = 0; }
#pragma unroll
        for (int ai = 0; ai < 2; ++ai)
#pragma unroll
            for (int m = 0; m < 4; ++m) { const int row = row0 + ai * HALF + m * 16; const float rinv = rsqrtf(row_ssq<64>(ssq_x, row, fq) * (1.0f / 4096.0f) + RMS_EPS);
                if (base) { float s = 0.f; bf16_t* rowp = base + (size_t)row * ldc + colt + cw;
#pragma unroll
                    for (int bj = 0; bj < 2; ++bj) { const f32x4 v0 = acc[ai][bj][m][0] * rinv, v1 = acc[ai][bj][m][1] * rinv; *(u32x4*)(rowp + bj * HALF) = pack8(v0, v1); s += sq4(v0) + sq4(v1); }
                    if (ssq) { s += __shfl_xor(s, 16); s += __shfl_xor(s, 32); if (fq == 0) ssq[(size_t)row * ns + slot] = s; }
                } else if (wc < 2) {
                    const f32x4 v0 = acc[ai][0][m][0] * rinv, v1 = acc[ai][0][m][1] * rinv; float* kp = kr + (size_t)row * 64 + cw; *(f32x4*)kp = v0; *(f32x4*)(kp + 4) = v1; }
            }
    }
};

struct EpiResidual {
    static constexpr bool PERM = true, AFTER_DRAIN = false;
    const float* base; float* out; bf16_t* xb; float* ssq;
    __device__ __forceinline__ void operator()(const f32x4 (&acc)[2][2][4][2], const Unit& u, int wr, int wc, int fr, int fq) const {
        const int row0 = u.pm * BM + wr * 64 + fr, col0 = u.pn * BM + wc * 32 + 8 * fq;
#pragma unroll
        for (int ai = 0; ai < 2; ++ai)
#pragma unroll
            for (int m = 0; m < 4; ++m) { const int row = row0 + ai * HALF + m * 16; const size_t off = (size_t)row * 4096 + col0; float s = 0.f;
#pragma unroll
                for (int bj = 0; bj < 2; ++bj) { const float* bp = base + off + bj * HALF; const f32x4 v0 = acc[ai][bj][m][0] + *(const f32x4*)bp, v1 = acc[ai][bj][m][1] + *(const f32x4*)(bp + 4);
                    float* op = out + off + bj * HALF; *(f32x4*)op = v0; *(f32x4*)(op + 4) = v1; *(u32x4*)(xb + off + bj * HALF) = pack8(v0, v1); s += sq4(v0) + sq4(v1); }
                s += __shfl_xor(s, 16); s += __shfl_xor(s, 32); if (fq == 0) ssq[(size_t)row * 64 + u.pn * 4 + wc] = s; }
    }
};

struct EpiSwiGLU {
    static constexpr bool PERM = true, AFTER_DRAIN = false;
    const float* ssq; bf16_t* act; int ldc;
    __device__ __forceinline__ static float silu(float x) { return x * __builtin_amdgcn_rcpf(1.0f + __expf(-x)); }
    __device__ __forceinline__ void operator()(const f32x4 (&acc)[2][2][4][2], const Unit& u, int wr, int wc, int fr, int fq) const {
        const int row0 = u.pm * BM + wr * 64 + fr, col0 = u.pn * HALF + wc * 32 + 8 * fq;
#pragma unroll
        for (int ai = 0; ai < 2; ++ai)
#pragma unroll
            for (int m = 0; m < 4; ++m) { const int row = row0 + ai * HALF + m * 16; const float rinv = rsqrtf(row_ssq<64>(ssq, row, fq) * (1.0f / 4096.0f) + RMS_EPS);
                f32x4 h0, h1;
#pragma unroll
                for (int e = 0; e < 4; ++e) { h0[e] = silu(acc[ai][0][m][0][e] * rinv) * (acc[ai][1][m][0][e] * rinv); h1[e] = silu(acc[ai][0][m][1][e] * rinv) * (acc[ai][1][m][1][e] * rinv); }
                *(u32x4*)(act + (size_t)row * ldc + col0) = pack8(h0, h1); }
    }
};

template <class Epi, class Sched, bool ALIGN_EPI = false, bool SP2 = false>
__device__ __forceinline__ void gemm_phase(PG8_LAS unsigned char* lds, const Gemm g, const Sched& S, const Epi& E) {
    int tid_ = threadIdx.x; asm volatile("" : "+v"(tid_));
    const int tid = tid_, wid = __builtin_amdgcn_readfirstlane(tid >> 6), lane = tid & 63, wr = wid >> 2, wc = wid & 3, fr = lane & 15, fq = lane >> 4;
    const int K = g.K, nt = K / BK;
    unsigned voffA[2], voffB[2];
#pragma unroll
    for (int i = 0; i < 2; ++i) { int R, C; stage_rc(tid * 16 + i * 8192, R, C); const int Rb = Epi::PERM ? ((R & ~31) + perm32(R & 31)) : R;
        voffA[i] = (unsigned)(R * K + C) * 2u; voffB[i] = (unsigned)(Rb * K + C) * 2u; }
    const size_t kstep = (size_t)(BK * 2);
    const size_t hstep = (size_t)HALF * K * 2;
    const size_t tstep = 2 * hstep;
    const unsigned ldsw = (unsigned)wid * 1024u;
    const int aoff = lds_byte(wr * 64 + fr, fq * 8), boff = lds_byte(wc * 32 + fr, fq * 8);
#define PG8_SA(b, h) (((b) * 2 + (h)) * HTB)
#define PG8_SB(b, h) ((4 + (b) * 2 + (h)) * HTB)
#define PG8_STAGE(bufoff, gbase, voff) do { _Pragma("unroll") for (int _i = 0; _i < 2; ++_i) \
        __builtin_amdgcn_global_load_lds((const unsigned*)((const char*)(gbase) + (voff)[_i]), (PG8_LAS unsigned*)(lds + (bufoff) + ldsw + _i * 8192), 16, 0, 0); } while (0)
#define PG8_LDA(dst, b, h) do { _Pragma("unroll") for (int m = 0; m < 4; ++m) _Pragma("unroll") for (int k = 0; k < 2; ++k) dst[m][k] = *(const PG8_LAS bf16x8*)(lds + PG8_SA(b, h) + aoff + m * 2048 + k * 1024); } while (0)
#define PG8_LDB(dst, b, h) do { _Pragma("unroll") for (int n = 0; n < 2; ++n) _Pragma("unroll") for (int k = 0; k < 2; ++k) dst[n][k] = *(const PG8_LAS bf16x8*)(lds + PG8_SB(b, h) + boff + n * 2048 + k * 1024); } while (0)
#define PG8_MMA(ai, bj, At, Bt) do { __builtin_amdgcn_s_setprio(1); _Pragma("unroll") for (int m = 0; m < 4; ++m) _Pragma("unroll") for (int n = 0; n < 2; ++n) _Pragma("unroll") for (int k = 0; k < 2; ++k) \
        acc[ai][bj][m][n] = __builtin_amdgcn_mfma_f32_16x16x32_bf16(Bt[n][k], At[m][k], acc[ai][bj][m][n], 0, 0, 0); __builtin_amdgcn_s_setprio(0); } while (0)
#define PG8_WAIT_V(n) asm volatile("s_waitcnt vmcnt(" #n ")" ::: "memory")
#define PG8_WAIT_L(n) asm volatile("s_waitcnt lgkmcnt(" #n ")" ::: "memory")
#define PG8_BAR __builtin_amdgcn_s_barrier()
#define PG8_SCHED __builtin_amdgcn_sched_barrier(0)
    Unit cur, nxt; int ui = 0;
    if (!S.next(0, cur)) return;
    f32x4 acc[2][2][4][2];
#pragma unroll
    for (int a = 0; a < 2; ++a)
#pragma unroll
        for (int b = 0; b < 2; ++b)
#pragma unroll
            for (int m = 0; m < 4; ++m)
#pragma unroll
                for (int n = 0; n < 2; ++n) acc[a][b][m][n] = (f32x4){0.f, 0.f, 0.f, 0.f};
    bf16x8 At[4][2], B0[2][2], B1[2][2];
    const char* cA = (const char*)g.A + (size_t)cur.pm * tstep; const char* cB = (const char*)g.Bt + (size_t)cur.pn * tstep;
    S.a_ready(cur);
    if constexpr (SP2) {
        PG8_STAGE(PG8_SB(0, 0), cB, voffB); PG8_STAGE(PG8_SB(0, 1), cB + hstep, voffB); PG8_STAGE(PG8_SA(0, 0), cA, voffA); PG8_STAGE(PG8_SA(0, 1), cA + hstep, voffA);
        if (wr == 1) PG8_BAR;
        PG8_WAIT_V(2); PG8_BAR;
        PG8_STAGE(PG8_SB(1, 0), cB + kstep, voffB); PG8_STAGE(PG8_SA(1, 0), cA + kstep, voffA); PG8_STAGE(PG8_SB(1, 1), cB + hstep + kstep, voffB);
        PG8_WAIT_V(6); PG8_BAR;
    } else {
        PG8_STAGE(PG8_SB(0, 0), cB, voffB); PG8_STAGE(PG8_SA(0, 0), cA, voffA); PG8_STAGE(PG8_SB(0, 1), cB + hstep, voffB); PG8_STAGE(PG8_SA(0, 1), cA + hstep, voffA);
        if (wr == 1) PG8_BAR;
        PG8_WAIT_V(4); PG8_BAR;
        PG8_STAGE(PG8_SB(1, 0), cB + kstep, voffB); PG8_STAGE(PG8_SA(1, 0), cA + kstep, voffA); PG8_STAGE(PG8_SB(1, 1), cB + hstep + kstep, voffB);
        PG8_WAIT_V(6); PG8_BAR;
    }
    for (;;) {
        const bool has_next = S.next(ui + 1, nxt);
        const char* nA = has_next ? (const char*)g.A + (size_t)nxt.pm * tstep : cA; const char* nB = has_next ? (const char*)g.Bt + (size_t)nxt.pn * tstep : cB;
        for (int t = 0; t < nt; t += 2) {
            const bool last = (t == nt - 2);
            const char* a1 = cA + (size_t)(t + 1) * kstep;
            const char* a2 = last ? nA : cA + (size_t)(t + 2) * kstep; const char* b2 = last ? nB : cB + (size_t)(t + 2) * kstep;
            const char* a3 = a2 + kstep; const char* b3 = b2 + kstep;
            if (last && has_next) S.a_ready(nxt);
            if constexpr (SP2) {
            PG8_LDB(B0, 0, 0); PG8_LDB(B1, 0, 1); PG8_SCHED; PG8_LDA(At, 0, 0); PG8_STAGE(PG8_SA(1, 1), a1 + hstep, voffA);
            PG8_WAIT_V(8); PG8_WAIT_L(0); PG8_BAR; PG8_MMA(0, 0, At, B0); PG8_MMA(0, 1, At, B1); PG8_BAR; PG8_SCHED;
            PG8_LDA(At, 0, 1); PG8_STAGE(PG8_SB(0, 0), b2, voffB); PG8_STAGE(PG8_SB(0, 1), b2 + hstep, voffB); PG8_STAGE(PG8_SA(0, 0), a2, voffA);
            PG8_WAIT_V(8); PG8_WAIT_L(0); PG8_BAR; PG8_MMA(1, 0, At, B0); PG8_MMA(1, 1, At, B1); PG8_BAR; PG8_SCHED;
            PG8_LDB(B0, 1, 0); PG8_LDB(B1, 1, 1); PG8_SCHED; PG8_LDA(At, 1, 0); PG8_STAGE(PG8_SA(0, 1), a2 + hstep, voffA);
            PG8_WAIT_V(8); PG8_WAIT_L(0); PG8_BAR; PG8_MMA(0, 0, At, B0); PG8_MMA(0, 1, At, B1); PG8_BAR; PG8_SCHED;
            PG8_LDA(At, 1, 1); PG8_STAGE(PG8_SB(1, 0), b3, voffB); PG8_STAGE(PG8_SB(1, 1), b3 + hstep, voffB); PG8_STAGE(PG8_SA(1, 0), a3, voffA);
            PG8_WAIT_V(8); PG8_WAIT_L(0); PG8_BAR; PG8_MMA(1, 0, At, B0); PG8_MMA(1, 1, At, B1); PG8_BAR; PG8_SCHED;
            } else {
            PG8_LDB(B0, 0, 0); PG8_SCHED; PG8_LDA(At, 0, 0); PG8_STAGE(PG8_SA(1, 1), a1 + hstep, voffA);
            PG8_WAIT_L(8); PG8_BAR; PG8_WAIT_L(0); PG8_MMA(0, 0, At, B0); PG8_BAR; PG8_SCHED;
            PG8_LDB(B1, 0, 1); PG8_STAGE(PG8_SB(0, 0), b2, voffB);
            PG8_BAR; PG8_WAIT_L(0); PG8_MMA(0, 1, At, B1); PG8_BAR;
            PG8_LDA(At, 0, 1); PG8_STAGE(PG8_SA(0, 0), a2, voffA);
            PG8_BAR; PG8_WAIT_L(0); PG8_MMA(1, 0, At, B0); PG8_BAR; PG8_SCHED;
            PG8_STAGE(PG8_SB(0, 1), b2 + hstep, voffB);
            PG8_WAIT_V(6); PG8_BAR; PG8_MMA(1, 1, At, B1); PG8_BAR;
            PG8_LDB(B0, 1, 0); PG8_SCHED; PG8_LDA(At, 1, 0); PG8_STAGE(PG8_SA(0, 1), a2 + hstep, voffA);
            PG8_WAIT_L(8); PG8_BAR; PG8_WAIT_L(0); PG8_MMA(0, 0, At, B0); PG8_BAR; PG8_SCHED;
            PG8_LDB(B1, 1, 1); PG8_STAGE(PG8_SB(1, 0), b3, voffB);
            PG8_BAR; PG8_WAIT_L(0); PG8_MMA(0, 1, At, B1); PG8_BAR;
            PG8_LDA(At, 1, 1); PG8_STAGE(PG8_SA(1, 0), a3, voffA);
            PG8_BAR; PG8_WAIT_L(0); PG8_MMA(1, 0, At, B0); PG8_BAR; PG8_SCHED;
            PG8_STAGE(PG8_SB(1, 1), b3 + hstep, voffB);
            PG8_WAIT_V(6); PG8_BAR; PG8_MMA(1, 1, At, B1); PG8_BAR;
            }
        }
        if constexpr (ALIGN_EPI) { if (wr == 0) PG8_BAR; }
        if constexpr (!Epi::AFTER_DRAIN) { E(acc, cur, wr, wc, fr, fq); S.done(cur); }
        if (!has_next) break;
#pragma unroll
        for (int a = 0; a < 2; ++a)
#pragma unroll
            for (int b = 0; b < 2; ++b)
#pragma unroll
                for (int m = 0; m < 4; ++m)
#pragma unroll
                    for (int n = 0; n < 2; ++n) acc[a][b][m][n] = (f32x4){0.f, 0.f, 0.f, 0.f};
        cur = nxt; cA = nA; cB = nB; ++ui;
        if constexpr (ALIGN_EPI) { if (wr == 1) PG8_BAR; }
    }
    PG8_WAIT_V(0);
    if constexpr (!ALIGN_EPI) { if (wr == 0) PG8_BAR; }
    PG8_BAR;
    if constexpr (Epi::AFTER_DRAIN) { E.fused(acc, cur, wr, wc, fr, fq, lds, wid, lane); S.done(cur); }
#undef PG8_SA
#undef PG8_SB
#undef PG8_STAGE
#undef PG8_LDA
#undef PG8_LDB
#undef PG8_MMA
#undef PG8_WAIT_V
#undef PG8_WAIT_L
#undef PG8_BAR
#undef PG8_SCHED
}
}
constexpr int NWAVES = 8;
constexpr int T = 8192, DM = 4096, SEQ = 2048, NBATCH = 4, MEMLEN = 256, TMEM = NBATCH * MEMLEN;
constexpr int QRANK = 1024, KVRANK = 512, NH = 16, QKD = 192, QUP_N = NH * QKD, KVUP_N = NH * 256;
constexpr int SBW = 2048, XW = 512, FF = 11008, IN_COLS = 7744, IN_PAD = 7936, DEPTH = 2;
constexpr int NPH = 11;
constexpr int N_PHASES = 1 + DEPTH * NPH;
#ifndef MK_PER_PHASE
#define MK_PER_PHASE 0
#endif

constexpr size_t MiB = 1u << 20;
constexpr size_t WS_CTL = 0, CTL_ZERO_BYTES = 1 * MiB;
constexpr size_t WL_IN = 0, WL_QUP = 62 * MiB, WL_KVUP = 68 * MiB, WL_OUT = 72 * MiB, WL_XQ = 104 * MiB, WL_XKV = 108 * MiB, WL_XO = 116 * MiB, WL_GU = 120 * MiB, WL_DN = 292 * MiB, WL_BYTES = 378 * MiB;
constexpr size_t WS_W = 2 * MiB;
constexpr size_t WS_XB = WS_W + DEPTH * WL_BYTES;
constexpr size_t WS_MEMB = WS_XB + 64 * MiB;
constexpr size_t WS_KVX = WS_MEMB + 8 * MiB;
constexpr size_t WS_QX = WS_KVX + 4 * MiB;
constexpr size_t WS_OX = WS_QX + 8 * MiB;
constexpr size_t WS_R1 = WS_OX + 8 * MiB;
constexpr size_t WS_CQ = WS_R1, WS_CKV = WS_CQ + 16 * MiB, WS_QSB = WS_CKV + 8 * MiB, WS_KSB = WS_QSB + 32 * MiB, WS_VSB = WS_KSB + 32 * MiB, WS_KR = WS_VSB + 32 * MiB;
constexpr size_t WS_QRAW = WS_KR + 2 * MiB, WS_KVRAW = WS_QRAW + 48 * MiB, WS_QM = WS_KVRAW + 64 * MiB, WS_KM = WS_QM + 48 * MiB, WS_O = WS_KM + 48 * MiB, WS_MIXED = WS_O + 128 * MiB;
constexpr size_t WS_R1_END = WS_MIXED + 64 * MiB;
constexpr size_t WS_ACT = WS_R1;
static_assert(WS_ACT + 172 * MiB <= WS_R1_END, "ACT fits in R1");
constexpr size_t WS_SSQX = WS_R1_END;
constexpr size_t WS_SSQCQ = WS_SSQX + 14 * MiB;
constexpr size_t WS_SSQCKV = WS_SSQCQ + 1 * MiB;
constexpr size_t WS_SSQMEM = WS_SSQCKV + 1 * MiB;
constexpr size_t WS_END = WS_SSQMEM + 1 * MiB;
constexpr int CW_TMO = 0, CW_CODE = 1, CW_BAR = 4096;
static_assert((CW_BAR + 3456) * 4 <= (int)CTL_ZERO_BYTES, "CTL words inside the memset region");

constexpr int RING_OFF = 0, RING_BYTES = 131072;
constexpr int LDSCTL_OFF = RING_BYTES, MISC_OFF = LDSCTL_OFF + 320;
constexpr int LDS_BYTES = 147456;
static_assert(MISC_OFF + 128 <= LDS_BYTES, "LDS map");
#define GAS __attribute__((address_space(1)))
#define LAS __attribute__((address_space(3)))
typedef unsigned short bf16;
typedef unsigned v4u __attribute__((ext_vector_type(4)));
typedef float f32x4 __attribute__((ext_vector_type(4)));
typedef short bf16x8 __attribute__((ext_vector_type(8)));
typedef GAS unsigned gu32;
typedef GAS unsigned long long gu64;
#define RLX_AGENT __ATOMIC_RELAXED, __HIP_MEMORY_SCOPE_AGENT
#define LDS_WAIT() asm volatile("s_waitcnt lgkmcnt(0)" ::: "memory")
#define VM_WAIT() asm volatile("s_waitcnt vmcnt(0)" ::: "memory")
__device__ __forceinline__ unsigned long long rt() { return __builtin_amdgcn_s_memrealtime(); }
__device__ __forceinline__ unsigned f2bf(float f) { unsigned u = __builtin_bit_cast(unsigned, f); return (u + 0x7fffu + ((u >> 16) & 1u)) >> 16; }
__device__ __forceinline__ unsigned pk2(float lo, float hi) { return f2bf(lo) | (f2bf(hi) << 16); }
#define XB_TMO      128
#define XB_XCNT(j)  (256  + 64 * (j))
#define XB_XSUB(j)  (1280 + 64 * (j))
#define XB_XGEN(j)  (2304 + 64 * (j))
#define XB_TOP      3328
#define XB_TOPGEN   3392
#define XCD_BAR_WORDS 3456
#define XB_SPIN_CAP (1u << 18)

__device__ __forceinline__ unsigned xb_ld(unsigned* p)              { return __hip_atomic_load(p, __ATOMIC_RELAXED, __HIP_MEMORY_SCOPE_AGENT); }
__device__ __forceinline__ unsigned xb_add(unsigned* p, unsigned v) { return __hip_atomic_fetch_add(p, v, __ATOMIC_RELAXED, __HIP_MEMORY_SCOPE_AGENT); }
__device__ __forceinline__ unsigned xb_xcc_id() { return (unsigned)__builtin_amdgcn_s_getreg((3 << 11) | 20) & 0xFu; }
#define XB_SPIN(cond, bar) do { unsigned _sp = 0; while (cond) { __builtin_amdgcn_s_sleep(1); \
    if ((++_sp & 255u) == 0u) { if (xb_ld(&(bar)[XB_TMO])) break; if (_sp > XB_SPIN_CAP) { atomicAdd(&(bar)[XB_TMO], 1u); break; } } } } while (0)

struct XcdBarrier {
    unsigned* bar; unsigned x;
    volatile LAS unsigned* st;
};

__device__ __forceinline__ XcdBarrier xcd_barrier_post(unsigned* bar, volatile LAS unsigned* st) {
    XcdBarrier b; b.bar = bar; b.x = xb_xcc_id(); b.st = st;
    if (threadIdx.x == 0) (void)xb_add(&bar[XB_XCNT(b.x)], 1u);
    return b;
}
__device__ __forceinline__ void xcd_barrier_complete(unsigned* bar, unsigned x, unsigned& nloc, unsigned& nx) {
    const unsigned G = gridDim.x * gridDim.y * gridDim.z;
    unsigned sum, cnt, mine, sp = 0u;
    for (;;) {
        sum = 0u; cnt = 0u; mine = 0u;
#pragma unroll
        for (unsigned j = 0; j < 16; ++j) { const unsigned c = xb_ld(&bar[XB_XCNT(j)]); sum += c; cnt += (c > 0u) ? 1u : 0u; mine = (j == x) ? c : mine; }
        if (sum == G) break;
        __builtin_amdgcn_s_sleep(1);
        if ((++sp & 255u) == 0u) { if (xb_ld(&bar[XB_TMO])) break; if (sp > XB_SPIN_CAP) { atomicAdd(&bar[XB_TMO], 1u); break; } }
    }
    nloc = mine > 0u ? mine : 1u; nx = cnt > 0u ? cnt : 1u;
}

__device__ __forceinline__ void xcd_barrier(const XcdBarrier& b) {
    asm volatile("s_waitcnt vmcnt(0)" ::: "memory");
    __syncthreads();
    if (threadIdx.x == 0) {
        unsigned* bar = b.bar;
        __builtin_amdgcn_s_waitcnt(0);
        unsigned nloc = b.st[0], nx = b.st[1];
        if (nloc == 0u) { xcd_barrier_complete(bar, b.x, nloc, nx); b.st[0] = nloc; b.st[1] = nx; }
        const unsigned old = xb_add(&bar[XB_XSUB(b.x)], 1u);
        const unsigned gen = old / nloc;
        if (old + 1u == (gen + 1u) * nloc) {
            __builtin_amdgcn_fence(__ATOMIC_RELEASE, "agent");
            asm volatile("s_waitcnt vmcnt(0)" ::: "memory");
            const unsigned og = xb_add(&bar[XB_TOP], 1u);
            const unsigned tg = og / nx;
            if (og + 1u == (tg + 1u) * nx) xb_add(&bar[XB_TOPGEN], 1u);
            else XB_SPIN(xb_ld(&bar[XB_TOPGEN]) == tg, bar);
            __builtin_amdgcn_fence(__ATOMIC_ACQUIRE, "agent");
            xb_add(&bar[XB_XGEN(b.x)], 1u);
            asm volatile("s_waitcnt vmcnt(0)" ::: "memory");
        } else {
            XB_SPIN(xb_ld(&bar[XB_XGEN(b.x)]) == gen, bar);
            __builtin_amdgcn_fence(__ATOMIC_ACQUIRE, "agent");
            asm volatile("s_waitcnt vmcnt(0)" ::: "memory");
        }
    }
    __syncthreads();
}
typedef unsigned u32x2 __attribute__((ext_vector_type(2)));
__device__ __forceinline__ float wave_sum(float v) {
#pragma unroll
    for (int o = 1; o < 64; o <<= 1) v += __shfl_xor(v, o);
    return v;
}
__device__ __forceinline__ float wave_max(float v) {
#pragma unroll
    for (int o = 1; o < 64; o <<= 1) v = fmaxf(v, __shfl_xor(v, o));
    return v;
}
__device__ __forceinline__ float bf_lo(unsigned w) { return __uint_as_float(w << 16); }
__device__ __forceinline__ float bf_hi(unsigned w) { return __uint_as_float(w & 0xffff0000u); }
__device__ __forceinline__ float bf2f(bf16 h) { return __uint_as_float((unsigned)h << 16); }

#define CAS __attribute__((address_space(4)))
struct Args { const float* in[25]; float* out; unsigned char* ws; int ph_lo, ph_hi, li, pad; };
typedef const CAS Args* ArgsP;
__device__ __forceinline__ int local_tid() { int t = threadIdx.x; asm volatile("" : "+v"(t)); return t; }
__device__ __forceinline__ ArgsP phase_args() { ArgsP p = (ArgsP)__builtin_amdgcn_kernarg_segment_ptr(); asm volatile("" : "+s"(p)); return p; }

__device__ __forceinline__ void tr_item(const float* W, int N, const float* g, bf16* WT, size_t ldk, int dst_row0, int kdst0, int k0, int n0, LAS float* scr, int lane) {
#pragma unroll 8
    for (int i = 0; i < 32; ++i) { const int kk = 2 * i + (lane >> 5); float w = W[(size_t)(k0 + kk) * N + n0 + (lane & 31)]; if (g) w *= g[k0 + kk]; scr[kk * 33 + (lane & 31)] = w; }
    LDS_WAIT(); asm volatile("" ::: "memory");
    const int c = lane & 7;
#pragma unroll
    for (int j = 0; j < 4; ++j) { const int n = (lane >> 3) + 8 * j; const LAS float* s = scr + (8 * c) * 33 + n;
        v4u o; o.x = pk2(s[0 * 33], s[1 * 33]); o.y = pk2(s[2 * 33], s[3 * 33]); o.z = pk2(s[4 * 33], s[5 * 33]); o.w = pk2(s[6 * 33], s[7 * 33]);
        *(GAS v4u*)(WT + (size_t)(dst_row0 + n) * ldk + kdst0 + 8 * c) = o; }
    LDS_WAIT(); asm volatile("" ::: "memory");
}
template <int MAP>
__device__ __forceinline__ void tr_matrix_item(const float* W, int K, int N, const float* g, bf16* WT, size_t ldk, int kdst_off, int r, LAS float* scr, int lane) {
    const int nblk = N / 32, kb = r / nblk, nb = r % nblk, k0 = 64 * kb, n0 = 32 * nb;
    int d0 = n0;
    if (MAP == 1) d0 = (n0 < 1536) ? n0 : (n0 < 1600 ? 7680 + (n0 - 1536) : n0 - 64);
    if (MAP == 2) d0 = (n0 >> 7) * 256 + (n0 & 127);
    if (MAP == 3) d0 = (n0 >> 7) * 256 + 128 + (n0 & 127);
    tr_item(W, N, g, WT, ldk, d0, kdst_off + k0, k0, n0, scr, lane);
}
__device__ __forceinline__ void row_to_bf16_ssq(const float* xrow, bf16* orow, float* ssq64, int lane) {
    const GAS f32x4* xr = (const GAS f32x4*)xrow + lane; GAS u32x2* o8 = (GAS u32x2*)orow + lane; float s = 0.f;
#pragma unroll 4
    for (int j = 0; j < 16; ++j) { const f32x4 v = xr[64 * j]; s += (v.x * v.x + v.y * v.y) + (v.z * v.z + v.w * v.w); u32x2 w; w.x = pk2(v.x, v.y); w.y = pk2(v.z, v.w); o8[64 * j] = w; }
    ssq64[lane] = s;
}
__device__ __forceinline__ void p0_prologue(ArgsP P, LAS unsigned char* lds) {
    const int tid = local_tid(), lane = tid & 63, wave = __builtin_amdgcn_readfirstlane(tid >> 6), gw = blockIdx.x * NWAVES + wave, NGW = gridDim.x * NWAVES;
    LAS float* scr = (LAS float*)(lds + RING_OFF + wave * 16384);
    unsigned char* ws = P->ws;
    constexpr int I_IN = (DM / 64) * (IN_COLS / 32), I_QUP = (QRANK / 64) * (QUP_N / 32), I_KVUP = (KVRANK / 64) * (KVUP_N / 32), I_OUTH = (2048 / 64) * (DM / 32);
    constexpr int I_XQ = (DM / 64) * (XW / 32), I_XKV = (DM / 64) * (1024 / 32), I_XO = (XW / 64) * (DM / 32), I_G = (DM / 64) * (FF / 32), I_DN = (FF / 64) * (DM / 32);
    constexpr int I_LAYER = I_IN + I_QUP + I_KVUP + 2 * I_OUTH + I_XQ + I_XKV + I_XO + 2 * I_G + I_DN;
    for (int it = gw; it < DEPTH * I_LAYER; it += NGW) {
        const int l = it / I_LAYER; int r = it % I_LAYER; unsigned char* wl = ws + WS_W + (size_t)l * WL_BYTES;
        if (r < I_IN) { tr_matrix_item<1>(P->in[4] + (size_t)l * DM * IN_COLS, DM, IN_COLS, P->in[3] + l * DM, (bf16*)(wl + WL_IN), DM, 0, r, scr, lane); continue; } r -= I_IN;
        if (r < I_QUP) { tr_matrix_item<0>(P->in[7] + (size_t)l * QRANK * QUP_N, QRANK, QUP_N, P->in[5] + l * QRANK, (bf16*)(wl + WL_QUP), QRANK, 0, r, scr, lane); continue; } r -= I_QUP;
        if (r < I_KVUP) { tr_matrix_item<0>(P->in[8] + (size_t)l * KVRANK * KVUP_N, KVRANK, KVUP_N, P->in[6] + l * KVRANK, (bf16*)(wl + WL_KVUP), KVRANK, 0, r, scr, lane); continue; } r -= I_KVUP;
        if (r < I_OUTH) { tr_matrix_item<0>(P->in[13] + (size_t)l * DM * DM, 2048, DM, P->in[11] + l * 2048, (bf16*)(wl + WL_OUT), DM, 0, r, scr, lane); continue; } r -= I_OUTH;
        if (r < I_OUTH) { tr_matrix_item<0>(P->in[13] + (size_t)l * DM * DM + (size_t)2048 * DM, 2048, DM, P->in[12] + l * 2048, (bf16*)(wl + WL_OUT), DM, 2048, r, scr, lane); continue; } r -= I_OUTH;
        if (r < I_XQ) { tr_matrix_item<0>(P->in[16] + (size_t)l * DM * XW, DM, XW, P->in[14] + l * DM, (bf16*)(wl + WL_XQ), DM, 0, r, scr, lane); continue; } r -= I_XQ;
        if (r < I_XKV) { tr_matrix_item<0>(P->in[17] + (size_t)l * DM * 1024, DM, 1024, P->in[15] + l * DM, (bf16*)(wl + WL_XKV), DM, 0, r, scr, lane); continue; } r -= I_XKV;
        if (r < I_XO) { tr_matrix_item<0>(P->in[20] + (size_t)l * XW * DM, XW, DM, nullptr, (bf16*)(wl + WL_XO), XW, 0, r, scr, lane); continue; } r -= I_XO;
        if (r < I_G) { tr_matrix_item<2>(P->in[22] + (size_t)l * DM * FF, DM, FF, P->in[21] + l * DM, (bf16*)(wl + WL_GU), DM, 0, r, scr, lane); continue; } r -= I_G;
        if (r < I_G) { tr_matrix_item<3>(P->in[23] + (size_t)l * DM * FF, DM, FF, P->in[21] + l * DM, (bf16*)(wl + WL_GU), DM, 0, r, scr, lane); continue; } r -= I_G;
        tr_matrix_item<0>(P->in[24] + (size_t)l * FF * DM, FF, DM, nullptr, (bf16*)(wl + WL_DN), FF, 0, r, scr, lane);
    }
    for (int c = gw * 64 + lane; c < DEPTH * 98304; c += NGW * 64) { const int l = c / 98304, cc = c % 98304;
        *(GAS v4u*)(ws + WS_W + (size_t)l * WL_BYTES + WL_IN + (size_t)IN_COLS * DM * 2 + (size_t)cc * 16) = (v4u){0u, 0u, 0u, 0u}; }
    for (int m = gw; m < T + TMEM; m += NGW) {
        if (m < T) row_to_bf16_ssq(P->in[0] + (size_t)m * DM, (bf16*)(ws + WS_XB) + (size_t)m * DM, (float*)(ws + WS_SSQX) + (size_t)m * 64, lane);
        else { const int mm = m - T; row_to_bf16_ssq(P->in[1] + (size_t)mm * DM, (bf16*)(ws + WS_MEMB) + (size_t)mm * DM, (float*)(ws + WS_SSQMEM) + (size_t)mm * 64, lane); }
    }
}

__device__ __forceinline__ void p_prep(ArgsP P, int l) {
    const int tid = local_tid(), lane = tid & 63, wave = __builtin_amdgcn_readfirstlane(tid >> 6), gw = blockIdx.x * NWAVES + wave, NGW = gridDim.x * NWAVES;
    unsigned char* ws = P->ws;
    const bf16* QRAW = (const bf16*)(ws + WS_QRAW); const bf16* KVRAW = (const bf16*)(ws + WS_KVRAW); const float* KR = (const float*)(ws + WS_KR);
    bf16* QM = (bf16*)(ws + WS_QM); bf16* KM = (bf16*)(ws + WS_KM);
    const float* gq = P->in[9] + l * QKD; const float* gk = P->in[10] + l * QKD; const int* pos = (const int*)P->in[2];
    const float inv_freq = powf(10000.0f, -(float)(lane & 31) / 32.0f);
    const float gq0 = gq[2 * lane], gq1 = gq[2 * lane + 1], gqr = gq[128 + lane], gk0 = gk[2 * lane], gk1 = gk[2 * lane + 1], gkr = gk[128 + lane];
    for (int row = gw; row < T; row += NGW) {
        const float ang = (float)pos[row] * inv_freq;
        double rv = (double)ang * 0.15915494309189535; rv -= rint(rv); const float fr = (float)rv;
        const float sn = __builtin_amdgcn_sinf(fr), cs = __builtin_amdgcn_cosf(fr);
        float krv;
        { const float v = KR[(size_t)row * 64 + lane]; const float ss = wave_sum(v * v); const float r = v * rsqrtf(ss * (1.0f / 64.0f) + 1e-6f) * gkr; const float pr = __shfl_xor(r, 32);
          krv = (lane < 32) ? r * cs - pr * sn : pr * sn + r * cs; }
        const unsigned short krb = (unsigned short)f2bf(krv);
        for (int h = 0; h < NH; ++h) {
            const bf16* q = QRAW + (size_t)row * QUP_N + h * QKD; bf16* qo = QM + (size_t)row * QUP_N + h * QKD;
            { const unsigned w = *(const unsigned*)(q + 2 * lane); const float a = bf_lo(w), b = bf_hi(w); const float ss = wave_sum(a * a + b * b); const float ri = rsqrtf(ss * (1.0f / 128.0f) + 1e-6f);
              *(unsigned*)(qo + 2 * lane) = pk2(a * ri * gq0, b * ri * gq1); }
            { const float v = bf2f(q[128 + lane]); const float ss = wave_sum(v * v); const float r = v * rsqrtf(ss * (1.0f / 64.0f) + 1e-6f) * gqr; const float pr = __shfl_xor(r, 32);
              const float o = (lane < 32) ? r * cs - pr * sn : pr * sn + r * cs; qo[128 + lane] = (unsigned short)f2bf(o); }
            const bf16* k = KVRAW + (size_t)row * KVUP_N + h * 256; bf16* ko = KM + (size_t)row * QUP_N + h * QKD;
            { const unsigned w = *(const unsigned*)(k + 2 * lane); const float a = bf_lo(w), b = bf_hi(w); const float ss = wave_sum(a * a + b * b); const float ri = rsqrtf(ss * (1.0f / 128.0f) + 1e-6f);
              *(unsigned*)(ko + 2 * lane) = pk2(a * ri * gk0, b * ri * gk1); }
            ko[128 + lane] = krb;
        }
    }
}

template <int DQK, int MODE, bool OUT_BF16>
__device__ __forceinline__ void naive_attn_item(LAS unsigned char* lds, int wave, int lane, int tid, const bf16* qrow, const bf16* Kb, size_t ldk, const bf16* Vb, size_t ldv,
                                                void* orow_, int i, int nt, float scale, const float* gq, const float* gk) {
    constexpr int KP2 = DQK / 2 + 1;
    LAS unsigned* Kt = (LAS unsigned*)lds;
    LAS unsigned* Vt = (LAS unsigned*)(lds + 64 * KP2 * 4);
    LAS float* qs = (LAS float*)(lds + 64 * KP2 * 4 + 16384) + wave * DQK;
    if (MODE == 1) {
        const unsigned w = *(const unsigned*)(qrow + 2 * lane); const float a = bf_lo(w), b = bf_hi(w); const float ss = wave_sum(a * a + b * b); const float ri = rsqrtf(ss * (1.0f / 128.0f) + 1e-6f) * scale;
        qs[2 * lane] = a * ri * gq[2 * lane] * gk[2 * lane]; qs[2 * lane + 1] = b * ri * gq[2 * lane + 1] * gk[2 * lane + 1];
    } else {
        for (int d = lane; d < DQK; d += 64) qs[d] = bf2f(qrow[d]) * scale;
    }
    float m = -1e30f, lsum = 0.f, o0 = 0.f, o1 = 0.f, carry = 0.f;
    for (int tt = 0; tt < nt; ++tt) {
        const int jt = (MODE == 2) ? nt - 1 - tt : tt;
        __syncthreads();
        constexpr int NCH = DQK / 8;
        for (int c = tid; c < 64 * NCH; c += NWAVES * 64) { const int r = c / NCH, cc = c % NCH; const v4u v = *(const GAS v4u*)(Kb + (size_t)(jt * 64 + r) * ldk + cc * 8);
            LAS unsigned* dst = Kt + r * KP2 + cc * 4; dst[0] = v.x; dst[1] = v.y; dst[2] = v.z; dst[3] = v.w; }
        for (int c = tid; c < 64 * 16; c += NWAVES * 64) { const int r = c / 16, cc = c % 16; const v4u v = *(const GAS v4u*)(Vb + (size_t)(jt * 64 + r) * ldv + cc * 8);
            *(LAS v4u*)(Vt + r * 64 + cc * 4) = v; }
        __syncthreads();
        float s = 0.f, kss = 0.f; const LAS unsigned* kr = Kt + lane * KP2;
#pragma unroll 8
        for (int d = 0; d < DQK / 2; ++d) { const unsigned kk = kr[d]; const float k0 = bf_lo(kk), k1 = bf_hi(kk); s += k0 * qs[2 * d] + k1 * qs[2 * d + 1]; if (MODE == 1) kss += k0 * k0 + k1 * k1; }
        if (MODE == 1) s *= rsqrtf(kss * (1.0f / 128.0f) + 1e-6f);
        const int j = jt * 64 + lane;
        float p;
        if (MODE == 2) {
            const bool strict = j < i;
            const float sp = fmaxf(s, 0.f) + log1pf(expf(-fabsf(s)));
            const float lk = strict ? -sp : 0.f;
            const float lb = s - sp;
            float v = lk;
#pragma unroll
            for (int off = 1; off < 64; off <<= 1) { const float t = __shfl_down(v, off); if (lane + off < 64) v += t; }
            const float excl = v - lk;
            p = strict ? expf(lb + excl + carry) : 0.f;
            carry += __shfl(v, 0);
        } else {
            if (MODE == 0 && j > i) s = -__builtin_inff();
            const float mx = wave_max(s), mn = fmaxf(m, mx), alpha = expf(m - mn);
            p = expf(s - mn); lsum = lsum * alpha + wave_sum(p); o0 *= alpha; o1 *= alpha; m = mn;
        }
#pragma unroll 8
        for (int jj = 0; jj < 64; ++jj) { const float pj = __shfl(p, jj); const unsigned vv = Vt[jj * 64 + lane]; o0 += pj * bf_lo(vv); o1 += pj * bf_hi(vv); }
    }
    if (MODE != 2) { const float il = 1.0f / lsum; o0 *= il; o1 *= il; }
    if (OUT_BF16) *((unsigned*)((bf16*)orow_ + 2 * lane)) = pk2(o0, o1);
    else { float* o = (float*)orow_; o[2 * lane] = o0; o[2 * lane + 1] = o1; }
}

__device__ __forceinline__ void p_attn_naive(ArgsP P, LAS unsigned char* lds) {
    const int tid = local_tid(), lane = tid & 63, wave = __builtin_amdgcn_readfirstlane(tid >> 6), G = gridDim.x;
    unsigned char* ws = P->ws;
    for (int it = blockIdx.x; it < 2 * 16384; it += G) {
        const int sb = it >= 16384, r = it & 16383, ib = 255 - (r >> 6), bh = r & 63, b = bh >> 4, h = bh & 15, i0 = ib * 8, row = b * SEQ + i0 + wave, nt = (i0 >> 6) + 1;
        float* orow = (float*)(ws + WS_O) + (size_t)row * DM + sb * 2048 + h * 128;
        if (!sb) naive_attn_item<192, 0, false>(lds, wave, lane, tid, (const bf16*)(ws + WS_QM) + (size_t)row * QUP_N + h * QKD, (const bf16*)(ws + WS_KM) + (size_t)b * SEQ * QUP_N + h * QKD, QUP_N,
                                                 (const bf16*)(ws + WS_KVRAW) + (size_t)b * SEQ * KVUP_N + h * 256 + 128, KVUP_N, orow, i0 + wave, nt, 0.07216878364870322f, nullptr, nullptr);
        else naive_attn_item<128, 2, false>(lds, wave, lane, tid, (const bf16*)(ws + WS_QSB) + (size_t)row * SBW + h * 128, (const bf16*)(ws + WS_KSB) + (size_t)b * SEQ * SBW + h * 128, SBW,
                                            (const bf16*)(ws + WS_VSB) + (size_t)b * SEQ * SBW + h * 128, SBW, orow, i0 + wave, nt, 0.08838834764831845f, nullptr, nullptr);
        __syncthreads();
    }
}
__device__ __forceinline__ void p_outnorm(ArgsP P) {
    const int tid = local_tid(), lane = tid & 63, wave = __builtin_amdgcn_readfirstlane(tid >> 6), gw = blockIdx.x * NWAVES + wave, NGW = gridDim.x * NWAVES;
    unsigned char* ws = P->ws;
    for (int row = gw; row < T; row += NGW)
#pragma unroll 1
        for (int half = 0; half < 2; ++half) {
            const GAS f32x4* o = (const GAS f32x4*)((const float*)(ws + WS_O) + (size_t)row * DM + half * 2048) + lane; f32x4 v[8]; float ss = 0.f;
#pragma unroll
            for (int j = 0; j < 8; ++j) { v[j] = o[64 * j]; ss += (v[j].x * v[j].x + v[j].y * v[j].y) + (v[j].z * v[j].z + v[j].w * v[j].w); }
            const float ri = rsqrtf(wave_sum(ss) * (1.0f / 2048.0f) + 1e-6f);
            GAS u32x2* d = (GAS u32x2*)((bf16*)(ws + WS_MIXED) + (size_t)row * DM + half * 2048) + lane;
#pragma unroll
            for (int j = 0; j < 8; ++j) { u32x2 w; w.x = pk2(v[j].x * ri, v[j].y * ri); w.y = pk2(v[j].z * ri, v[j].w * ri); d[64 * j] = w; }
        }
}
__device__ __forceinline__ void p_xattn_naive(ArgsP P, int l, LAS unsigned char* lds) {
    const int tid = local_tid(), lane = tid & 63, wave = __builtin_amdgcn_readfirstlane(tid >> 6), G = gridDim.x;
    unsigned char* ws = P->ws; const float* gq = P->in[18] + l * 128; const float* gk = P->in[19] + l * 128;
    for (int it = blockIdx.x; it < 4096; it += G) {
        const int ib = it >> 4, bh = it & 15, b = bh >> 2, h = bh & 3, row = b * SEQ + ib * 8 + wave;
        const bf16* KV = (const bf16*)(ws + WS_KVX) + (size_t)l * TMEM * 1024 + (size_t)b * MEMLEN * 1024 + h * 256;
        naive_attn_item<128, 1, true>(lds, wave, lane, tid, (const bf16*)(ws + WS_QX) + (size_t)row * XW + h * 128, KV, 1024, KV + 128, 1024,
                                      (bf16*)(ws + WS_OX) + (size_t)row * XW + h * 128, 0, 4, 0.08838834764831845f, gq, gk);
        __syncthreads();
    }
}

#ifndef PH_MASK
#define PH_MASK 0xFFF
#endif
#define EN(k) (((PH_MASK) >> (k)) & 1)
__global__ void __launch_bounds__(NWAVES * 64, 2) fwd(Args args) {
    extern __shared__ __attribute__((aligned(16))) unsigned char lds_raw[];
    LAS unsigned char* lds = (LAS unsigned char*)lds_raw;
    volatile LAS unsigned* MISC = (volatile LAS unsigned*)(lds + MISC_OFF);
    const int tid = threadIdx.x, G = gridDim.x;
    for (int u = tid; u < (LDS_BYTES - LDSCTL_OFF) / 4; u += NWAVES * 64) ((LAS unsigned*)(lds + LDSCTL_OFF))[u] = 0u;
    __syncthreads();
    XcdBarrier bar;
    { gu32* ctl = (gu32*)(args.ws + WS_CTL); bar.bar = (unsigned*)(ctl + CW_BAR); bar.x = 0; bar.st = nullptr;
      if (!MK_PER_PHASE) bar = xcd_barrier_post((unsigned*)(ctl + CW_BAR), MISC + 8); }
#define GRID_BAR() do { if (MK_PER_PHASE) { if (tid == 0) __hip_atomic_store((gu32*)bar.bar, 0xBADBA0u, RLX_AGENT); } else { xcd_barrier(bar); } } while (0)
    const int lo = args.ph_lo, hi = args.ph_hi;
#define IN(k) (lo <= (k) && (k) < hi)
#define BOTH(k) (IN(k) && IN((k) + 1))
#define SSQX(j) ((float*)(ws + WS_SSQX) + (size_t)(l * 3 + (j)) * T * 64)

    if (EN(0) && IN(0)) { p0_prologue(phase_args(), lds); if (BOTH(0)) GRID_BAR(); }

    for (int l = 0; l < DEPTH; ++l) {
        const int pb = 1 + l * NPH;
        if (EN(1) && IN(pb + 0)) {
            { ArgsP A = phase_args(); unsigned char* ws = A->ws; unsigned char* wl = ws + WS_W + (size_t)l * WL_BYTES;
              pg8::Gemm g{(const bf16*)(ws + WS_XB), (const bf16*)(wl + WL_IN), T, IN_PAD, DM}; pg8::StaticOrder S; S.init(T, IN_PAD, G, (int)blockIdx.x);
              pg8::EpiInProj E{SSQX(0), (bf16*)(ws + WS_CQ), (bf16*)(ws + WS_CKV), (bf16*)(ws + WS_QSB), (bf16*)(ws + WS_KSB), (bf16*)(ws + WS_VSB), (float*)(ws + WS_KR), (float*)(ws + WS_SSQCQ) + (size_t)l * T * 16, (float*)(ws + WS_SSQCKV) + (size_t)l * T * 8};
              pg8::gemm_phase<pg8::EpiInProj, pg8::StaticOrder, true, true>(lds + RING_OFF, g, S, E); }
            { ArgsP A = phase_args(); unsigned char* ws = A->ws; unsigned char* wl = ws + WS_W + (size_t)l * WL_BYTES;
              pg8::Gemm g{(const bf16*)(ws + WS_MEMB), (const bf16*)(wl + WL_XKV), TMEM, 1024, DM}; pg8::StaticOrder S; S.init(TMEM, 1024, G, (int)blockIdx.x);
              pg8::EpiScaleBf16<64> E{(const float*)(ws + WS_SSQMEM), 1.0f / 4096.0f, (bf16*)(ws + WS_KVX) + (size_t)l * TMEM * 1024, 1024};
              pg8::gemm_phase<pg8::EpiScaleBf16<64>, pg8::StaticOrder, true, true>(lds + RING_OFF, g, S, E); }
            if (BOTH(pb + 0)) GRID_BAR();
        }
        if (EN(2) && IN(pb + 1)) {
            { ArgsP A = phase_args(); unsigned char* ws = A->ws; unsigned char* wl = ws + WS_W + (size_t)l * WL_BYTES;
              pg8::Gemm g{(const bf16*)(ws + WS_CQ), (const bf16*)(wl + WL_QUP), T, QUP_N, QRANK}; pg8::StaticOrder S; S.init(T, QUP_N, G, (int)blockIdx.x);
              pg8::EpiScaleBf16<16> E{(const float*)(ws + WS_SSQCQ) + (size_t)l * T * 16, 1.0f / 1024.0f, (bf16*)(ws + WS_QRAW), QUP_N};
              pg8::gemm_phase<pg8::EpiScaleBf16<16>, pg8::StaticOrder, true, true>(lds + RING_OFF, g, S, E); }
            { ArgsP A = phase_args(); unsigned char* ws = A->ws; unsigned char* wl = ws + WS_W + (size_t)l * WL_BYTES;
              pg8::Gemm g{(const bf16*)(ws + WS_CKV), (const bf16*)(wl + WL_KVUP), T, KVUP_N, KVRANK}; pg8::StaticOrder S; S.init(T, KVUP_N, G, (int)blockIdx.x);
              pg8::EpiScaleBf16<8> E{(const float*)(ws + WS_SSQCKV) + (size_t)l * T * 8, 1.0f / 512.0f, (bf16*)(ws + WS_KVRAW), KVUP_N};
              pg8::gemm_phase<pg8::EpiScaleBf16<8>, pg8::StaticOrder, true, true>(lds + RING_OFF, g, S, E); }
            if (BOTH(pb + 1)) GRID_BAR();
        }
        if (EN(3) && IN(pb + 2)) { p_prep(phase_args(), l); if (BOTH(pb + 2)) GRID_BAR(); }
        if (EN(4) && IN(pb + 3)) { p_attn_naive(phase_args(), lds); if (BOTH(pb + 3)) GRID_BAR(); }
        if (EN(5) && IN(pb + 4)) { p_outnorm(phase_args()); if (BOTH(pb + 4)) GRID_BAR(); }
        if (EN(6) && IN(pb + 5)) {
            ArgsP A = phase_args(); unsigned char* ws = A->ws; unsigned char* wl = ws + WS_W + (size_t)l * WL_BYTES; float* out = A->out;
            pg8::Gemm g{(const bf16*)(ws + WS_MIXED), (const bf16*)(wl + WL_OUT), T, DM, DM}; pg8::StaticOrder S; S.init(T, DM, G, (int)blockIdx.x);
            pg8::EpiResidual E{l == 0 ? A->in[0] : (const float*)out, out, (bf16*)(ws + WS_XB), SSQX(1)};
            pg8::gemm_phase<pg8::EpiResidual, pg8::StaticOrder, true, true>(lds + RING_OFF, g, S, E);
            if (BOTH(pb + 5)) GRID_BAR();
        }
        if (EN(7) && IN(pb + 6)) {
            ArgsP A = phase_args(); unsigned char* ws = A->ws; unsigned char* wl = ws + WS_W + (size_t)l * WL_BYTES;
            pg8::Gemm g{(const bf16*)(ws + WS_XB), (const bf16*)(wl + WL_XQ), T, XW, DM}; pg8::StaticOrder S; S.init(T, XW, G, (int)blockIdx.x);
            pg8::EpiScaleBf16<64> E{SSQX(1), 1.0f / 4096.0f, (bf16*)(ws + WS_QX), XW};
            pg8::gemm_phase<pg8::EpiScaleBf16<64>, pg8::StaticOrder, true, true>(lds + RING_OFF, g, S, E);
            if (BOTH(pb + 6)) GRID_BAR();
        }
        if (EN(8) && IN(pb + 7)) { p_xattn_naive(phase_args(), l, lds); if (BOTH(pb + 7)) GRID_BAR(); }
        if (EN(9) && IN(pb + 8)) {
            ArgsP A = phase_args(); unsigned char* ws = A->ws; unsigned char* wl = ws + WS_W + (size_t)l * WL_BYTES; float* out = A->out;
            pg8::Gemm g{(const bf16*)(ws + WS_OX), (const bf16*)(wl + WL_XO), T, DM, XW}; pg8::StaticOrder S; S.init(T, DM, G, (int)blockIdx.x);
            pg8::EpiResidual E{out, out, (bf16*)(ws + WS_XB), SSQX(2)};
            pg8::gemm_phase<pg8::EpiResidual, pg8::StaticOrder, true, true>(lds + RING_OFF, g, S, E);
            if (BOTH(pb + 8)) GRID_BAR();
        }
        if (EN(10) && IN(pb + 9)) {
            ArgsP A = phase_args(); unsigned char* ws = A->ws; unsigned char* wl = ws + WS_W + (size_t)l * WL_BYTES;
            pg8::Gemm g{(const bf16*)(ws + WS_XB), (const bf16*)(wl + WL_GU), T, 2 * FF, DM}; pg8::StaticOrder S; S.init(T, 2 * FF, G, (int)blockIdx.x);
            pg8::EpiSwiGLU E{SSQX(2), (bf16*)(ws + WS_ACT), FF};
            pg8::gemm_phase<pg8::EpiSwiGLU, pg8::StaticOrder, true, true>(lds + RING_OFF, g, S, E);
            if (BOTH(pb + 9)) GRID_BAR();
        }
        if (EN(11) && IN(pb + 10)) {
            ArgsP A = phase_args(); unsigned char* ws = A->ws; unsigned char* wl = ws + WS_W + (size_t)l * WL_BYTES; float* out = A->out;
            pg8::Gemm g{(const bf16*)(ws + WS_ACT), (const bf16*)(wl + WL_DN), T, DM, FF}; pg8::StaticOrder S; S.init(T, DM, G, (int)blockIdx.x);
            pg8::EpiResidual E{out, out, (bf16*)(ws + WS_XB), SSQX(3)};
            pg8::gemm_phase<pg8::EpiResidual, pg8::StaticOrder, true, true>(lds + RING_OFF, g, S, E);
            if (BOTH(pb + 10)) GRID_BAR();
        }
    }
#undef IN
#undef BOTH
}

__global__ void dbg_dump(const float* src, float* dst, size_t n) { for (size_t i = (size_t)blockIdx.x * blockDim.x + threadIdx.x; i < n; i += (size_t)gridDim.x * blockDim.x) dst[i] = src[i]; }
extern "C" void kernel_launch(void* const* d_in, const int* in_sizes, int n_in, void* d_out, int out_size, void* d_ws, size_t ws_size, hipStream_t stream) {
    static int grid = 0;
    if (grid == 0) {
        if (n_in != 25 || in_sizes[0] != T * DM || out_size != T * DM || ws_size < WS_END) { fprintf(stderr, "kernel_launch: unexpected shapes (n_in %d, in0 %d, out %d, ws %zu < %zu); nothing launched\n", n_in, n_in > 0 ? in_sizes[0] : -1, out_size, ws_size, (size_t)WS_END); grid = -1; return; }
        int dev = 0, cus = 0, per_cu = 0;
        if (hipGetDevice(&dev) != hipSuccess || hipDeviceGetAttribute(&cus, hipDeviceAttributeMultiprocessorCount, dev) != hipSuccess) { grid = -1; return; }
        if (hipFuncSetAttribute((const void*)fwd, hipFuncAttributeMaxDynamicSharedMemorySize, LDS_BYTES) != hipSuccess) { fprintf(stderr, "kernel_launch: hipFuncSetAttribute failed\n"); grid = -1; return; }
        if (hipOccupancyMaxActiveBlocksPerMultiprocessor(&per_cu, (const void*)fwd, NWAVES * 64, LDS_BYTES) != hipSuccess || per_cu < 1) { fprintf(stderr, "kernel_launch: occupancy query reports %d\n", per_cu); }
        (void)hipGetLastError();
        grid = cus;
    }
    if (grid < 0) return;
    if (hipMemsetAsync((char*)d_ws + WS_CTL, 0, CTL_ZERO_BYTES, stream) != hipSuccess) { fprintf(stderr, "kernel_launch: memset failed\n"); return; }
    Args a{};
    for (int i = 0; i < 25; ++i) a.in[i] = (const float*)d_in[i];
    a.out = (float*)d_out; a.ws = (unsigned char*)d_ws; a.pad = 0;
#if MK_PER_PHASE
#ifndef DBG_STOP
#define DBG_STOP N_PHASES
#endif
    for (int p = 0; p < DBG_STOP; ++p) { a.ph_lo = p; a.ph_hi = p + 1; a.li = p; hipLaunchKernelGGL(fwd, dim3(grid), dim3(NWAVES * 64), LDS_BYTES, stream, a); }
#ifdef DBG_DUMP_OFF
    hipLaunchKernelGGL(dbg_dump, dim3(1024), dim3(256), 0, stream, (const float*)((const char*)d_ws + (size_t)(DBG_DUMP_OFF)), (float*)d_out, (size_t)T * DM);
#endif
#else
    a.ph_lo = 0; a.ph_hi = N_PHASES; a.li = 0;
    hipLaunchKernelGGL(fwd, dim3(grid), dim3(NWAVES * 64), LDS_BYTES, stream, a);
#endif
    const hipError_t le = hipPeekAtLastError();
    if (le != hipSuccess) fprintf(stderr, "kernel_launch: launch failed: %s\n", hipGetErrorName(le));
}
```

```cpp
#include <hip/hip_runtime.h>
#include <cstdio>
#include <cstdint>
namespace pg8 {
#define PG8_LAS __attribute__((address_space(3)))
typedef unsigned short bf16_t;
typedef short bf16x8 __attribute__((ext_vector_type(8)));
typedef float f32x4 __attribute__((ext_vector_type(4)));
typedef unsigned u32x4 __attribute__((ext_vector_type(4)));
constexpr int BM = 256, BK = 64, HALF = 128, HTB = HALF * BK * 2  , STAGE_BYTES = 8 * HTB, NXCD = 8, WGM = 8;

__host__ __device__ __forceinline__ int lds_byte(int r, int c) { const int st = (r >> 4) * 2 + (c >> 5), rr = r & 15, cc = c & 31, ob = rr * 64 + cc * 2; return st * 1024 + (ob ^ (((ob >> 9) & 1) << 5)); }
__host__ __device__ __forceinline__ void stage_rc(int b, int& R, int& C) { const int st = b / 1024, sb = b % 1024, swz = sb ^ (((sb >> 9) & 1) << 5); R = (st >> 1) * 16 + swz / 64; C = (st & 1) * 32 + (swz % 64) / 2; }
__host__ __device__ __forceinline__ int perm32(int rho) { const int n = rho >> 4, i = rho & 15; return 8 * (i >> 2) + 4 * n + (i & 3); }

struct Unit { int pm, pn; int ks = 0; };
struct Gemm { const bf16_t* A; const bf16_t* Bt; int M, N, K; int ld = 0; };

struct StaticOrder {
    int nM, nN, nwg, G, c;
    int i0 = 0, i1 = 1 << 28;
    int ksplit = 0;
    __host__ __device__ void init(int M, int N, int G_, int c_) { nM = M / BM; nN = N / BM; nwg = nM * nN; G = G_; c = c_; }
    __host__ __device__ bool next(int i, Unit& u) const {
        const int rnd = (ksplit ? (i >> 1) : i) + i0; if (rnd >= i1) return false;
        const long L = (long)rnd * G + c; if (L >= nwg) return false; u.ks = ksplit ? (i & 1) : 0;
        int wgid = (int)L; { const int q = nwg / NXCD, r = nwg % NXCD, xcd = wgid % NXCD, off = wgid / NXCD; wgid = (xcd < r ? xcd * (q + 1) : r * (q + 1) + (xcd - r) * q) + off; }
        const int nig = WGM * nN, gid = wgid / nig, fm = gid * WGM, gsz = (nM - fm) < WGM ? (nM - fm) : WGM;
        u.pm = fm + ((wgid % nig) % gsz); u.pn = (wgid % nig) / gsz; return true;
    }
    __device__ __forceinline__ void a_ready(const Unit&) const {}
    __device__ __forceinline__ void done(const Unit&) const {}
};

__device__ __forceinline__ unsigned cvt_pk_bf16(float lo, float hi) { unsigned r; asm volatile("v_cvt_pk_bf16_f32 %0, %1, %2" : "=v"(r) : "v"(lo), "v"(hi)); return r; }
constexpr float RMS_EPS = 1e-6f;
__device__ __forceinline__ float ld_sc1(const float* p) { return __hip_atomic_load(p, __ATOMIC_RELAXED, __HIP_MEMORY_SCOPE_AGENT); }
__device__ __forceinline__ void add_f32(float* p, float v) { (void)__hip_atomic_fetch_add(p, v, __ATOMIC_RELAXED, __HIP_MEMORY_SCOPE_AGENT); }
__device__ __forceinline__ float sq4(const f32x4 v) { return (v[0] * v[0] + v[1] * v[1]) + (v[2] * v[2] + v[3] * v[3]); }
__device__ __forceinline__ u32x4 pack8(const f32x4 a, const f32x4 b) { u32x4 w; w.x = cvt_pk_bf16(a[0], a[1]); w.y = cvt_pk_bf16(a[2], a[3]); w.z = cvt_pk_bf16(b[0], b[1]); w.w = cvt_pk_bf16(b[2], b[3]); return w; }

template <int NS>
__device__ __forceinline__ float row_ssq(const float* part, int row, int fq) {
    float s = 0.f;
    if constexpr (NS >= 16) { constexpr int PER = NS / 4; const f32x4* p = (const f32x4*)(part + (size_t)row * NS + fq * PER);
#pragma unroll
        for (int i = 0; i < PER / 4; ++i) { const f32x4 v = p[i]; s += (v[0] + v[1]) + (v[2] + v[3]); } }
    else { static_assert(NS == 8, "NS"); if (fq < 2) { const f32x4 v = *(const f32x4*)(part + (size_t)row * 8 + fq * 4); s = (v[0] + v[1]) + (v[2] + v[3]); } }
    s += __shfl_xor(s, 16); s += __shfl_xor(s, 32); return s;
}
template <int NS>
__device__ __forceinline__ void row_rinv8(float (&rinv)[8], const float* ssq, float inv_n, int row0, int fr, int fq, PG8_LAS float* cache, int tag) {
    if (((const PG8_LAS int*)cache)[128] == tag) {
#pragma unroll
        for (int i = 0; i < 8; ++i) rinv[i] = cache[(i >> 2) * 64 + (i & 3) * 16 + fr];
    } else {
#pragma unroll
        for (int i = 0; i < 8; ++i) { const float r = rsqrtf(row_ssq<NS>(ssq, row0 + (i >> 2) * HALF + (i & 3) * 16, fq) * inv_n + RMS_EPS); rinv[i] = r; if (fq == 0) cache[(i >> 2) * 64 + (i & 3) * 16 + fr] = r; }
        if (fr == 0 && fq == 0) ((PG8_LAS int*)cache)[128] = tag;
    }
}
template <int NS> struct EpiScaleBf16 {
    static constexpr bool PERM = true, AFTER_DRAIN = false;
    const float* ssq; float inv_n; bf16_t* O; int ldc;
    __device__ __forceinline__ void operator()(const f32x4 (&acc)[2][2][4][2], const Unit& u, int wr, int wc, int fr, int fq) const {
        const int row0 = u.pm * BM + wr * 64 + fr, col0 = u.pn * BM + wc * 32 + 8 * fq;
#pragma unroll
        for (int ai = 0; ai < 2; ++ai)
#pragma unroll
            for (int m = 0; m < 4; ++m) { const int row = row0 + ai * HALF + m * 16; const float rinv = rsqrtf(row_ssq<NS>(ssq, row, fq) * inv_n + RMS_EPS);
                bf16_t* rowp = O + (size_t)row * ldc + col0;
#pragma unroll
                for (int bj = 0; bj < 2; ++bj) *(u32x4*)(rowp + bj * HALF) = pack8(acc[ai][bj][m][0] * rinv, acc[ai][bj][m][1] * rinv); }
    }
};

struct EpiInProj {
    static constexpr bool PERM = true, AFTER_DRAIN = false;
    const float* ssq_x; bf16_t *cq, *ckv, *qsb, *ksb, *vsb; float* kr; float *ssq_cq, *ssq_ckv; PG8_LAS unsigned char* rcache; int tagbase;
    __device__ __forceinline__ void operator()(const f32x4 (&acc)[2][2][4][2], const Unit& u, int wr, int wc, int fr, int fq) const {
        const int pn = u.pn, row0 = u.pm * BM + wr * 64 + fr, cw = wc * 32 + 8 * fq;
        bf16_t* base; int ldc, colt; float* ssq = nullptr; int ns = 0, slot = 0;
        if (pn < 4) { base = cq; ldc = 1024; colt = pn * 256; ssq = ssq_cq; ns = 16; slot = pn * 4 + wc; }
        else if (pn < 6) { base = ckv; ldc = 512; colt = (pn - 4) * 256; ssq = ssq_ckv; ns = 8; slot = (pn - 4) * 4 + wc; }
        else if (pn < 14) { base = qsb; ldc = 2048; colt = (pn - 6) * 256; }
        else if (pn < 22) { base = ksb; ldc = 2048; colt = (pn - 14) * 256; }
        else if (pn < 30) { base = vsb; ldc = 2048; colt = (pn - 22) * 256; }
        else { base = nullptr; ldc = 0; colt = 0; }
        float rinv8[8]; row_rinv8<64>(rinv8, ssq_x, 1.0f / 4096.0f, row0, fr, fq, (PG8_LAS float*)(rcache + (wr * 4 + wc) * 528), tagbase + pn * 0 + u.pm);
#pragma unroll
        for (int ai = 0; ai < 2; ++ai)
#pragma unroll
            for (int m = 0; m < 4; ++m) { const int row = row0 + ai * HALF + m * 16; const float rinv = rinv8[ai * 4 + m];
                if (base) { float s = 0.f; bf16_t* rowp = base + (size_t)row * ldc + colt + cw;
#pragma unroll
                    for (int bj = 0; bj < 2; ++bj) { const f32x4 v0 = acc[ai][bj][m][0] * rinv, v1 = acc[ai][bj][m][1] * rinv; *(u32x4*)(rowp + bj * HALF) = pack8(v0, v1); s += sq4(v0) + sq4(v1); }
                    if (ssq) { s += __shfl_xor(s, 16); s += __shfl_xor(s, 32); if (fq == 0) ssq[(size_t)row * ns + slot] = s; }
                } else if (wc < 2) {
                    const f32x4 v0 = acc[ai][0][m][0] * rinv, v1 = acc[ai][0][m][1] * rinv; float* kp = kr + (size_t)row * 64 + cw; *(f32x4*)kp = v0; *(f32x4*)(kp + 4) = v1; }
            }
    }
};

struct EpiKvUp {
    static constexpr bool PERM = true, AFTER_DRAIN = false;
    const float* ssq; bf16_t* O; const float* gk; PG8_LAS float* xch;
    __device__ __forceinline__ void operator()(const f32x4 (&acc)[2][2][4][2], const Unit& u, int wr, int wc, int fr, int fq) const {
        const int row0 = u.pm * BM + wr * 64 + fr, col0 = u.pn * BM + wc * 32 + 8 * fq;
        float rinv[8];
#pragma unroll
        for (int i = 0; i < 8; ++i) rinv[i] = rsqrtf(row_ssq<8>(ssq, row0 + (i >> 2) * HALF + (i & 3) * 16, fq) * (1.0f / 512.0f) + RMS_EPS);
#pragma unroll
        for (int i = 0; i < 8; ++i) { const int ai = i >> 2, m = i & 3; const f32x4 k0 = acc[ai][0][m][0] * rinv[i], k1 = acc[ai][0][m][1] * rinv[i]; float s = sq4(k0) + sq4(k1);
            s += __shfl_xor(s, 16); s += __shfl_xor(s, 32); if (fq == 0) xch[(ai * HALF + wr * 64 + m * 16 + fr) * 4 + wc] = s;
            *(u32x4*)(O + (size_t)(row0 + ai * HALF + m * 16) * 4096 + col0 + HALF) = pack8(acc[ai][1][m][0] * rinv[i], acc[ai][1][m][1] * rinv[i]); }
        asm volatile("s_waitcnt lgkmcnt(0)\n\ts_barrier" ::: "memory");
        const f32x4 g0 = *(const f32x4*)(gk + wc * 32 + 8 * fq), g1 = *(const f32x4*)(gk + wc * 32 + 8 * fq + 4);
#pragma unroll
        for (int i = 0; i < 8; ++i) { const int ai = i >> 2, m = i & 3; const f32x4 p = *(const PG8_LAS f32x4*)(xch + (ai * HALF + wr * 64 + m * 16 + fr) * 4);
            const float rk = rsqrtf(((p[0] + p[1]) + (p[2] + p[3])) * (1.0f / 128.0f) + RMS_EPS) * rinv[i];
            *(u32x4*)(O + (size_t)(row0 + ai * HALF + m * 16) * 4096 + col0) = pack8(acc[ai][0][m][0] * rk * g0, acc[ai][0][m][1] * rk * g1); }
        asm volatile("s_waitcnt lgkmcnt(0)\n\ts_barrier" ::: "memory");
    }
};

__device__ __forceinline__ void unpack8(const u32x4 w, f32x4& a, f32x4& b) {
    a[0] = __uint_as_float(w.x << 16); a[1] = __uint_as_float(w.x & 0xffff0000u); a[2] = __uint_as_float(w.y << 16); a[3] = __uint_as_float(w.y & 0xffff0000u);
    b[0] = __uint_as_float(w.z << 16); b[1] = __uint_as_float(w.z & 0xffff0000u); b[2] = __uint_as_float(w.w << 16); b[3] = __uint_as_float(w.w & 0xffff0000u);
}
struct EpiResidual {
    static constexpr bool PERM = true, AFTER_DRAIN = false;
    float* out; bf16_t* xb; float* ssq;
    __device__ __forceinline__ void operator()(const f32x4 (&acc)[2][2][4][2], const Unit& u, int wr, int wc, int fr, int fq) const {
        const int row0 = u.pm * BM + wr * 64 + fr, col0 = u.pn * BM + wc * 32 + 8 * fq;
#pragma unroll
        for (int ai = 0; ai < 2; ++ai)
#pragma unroll
            for (int m = 0; m < 4; ++m) { const int row = row0 + ai * HALF + m * 16; const size_t off = (size_t)row * 4096 + col0; float s = 0.f;
#pragma unroll
                for (int bj = 0; bj < 2; ++bj) { bf16_t* xp = xb + off + bj * HALF; f32x4 b0, b1; unpack8(*(const u32x4*)xp, b0, b1); const f32x4 v0 = acc[ai][bj][m][0] + b0, v1 = acc[ai][bj][m][1] + b1;
                    if (out) { float* op = out + off + bj * HALF; *(f32x4*)op = v0; *(f32x4*)(op + 4) = v1; } else { *(u32x4*)xp = pack8(v0, v1); s += sq4(v0) + sq4(v1); } }
                if (!out) { s += __shfl_xor(s, 16); s += __shfl_xor(s, 32); if (fq == 0) ssq[(size_t)row * 64 + u.pn * 4 + wc] = s; } }
    }
};

struct EpiResidual2 {
    static constexpr bool PERM = true, AFTER_DRAIN = false;
    bf16_t* xb; float* ssq; const float* osq;
    __device__ __forceinline__ void operator()(const f32x4 (&acc)[2][2][4][2], const Unit& u, int wr, int wc, int fr, int fq) const {
        const int row0 = u.pm * BM + wr * 64 + fr, col0 = u.pn * BM + wc * 32 + 8 * fq; const bool second = u.ks != 0;
#pragma unroll
        for (int ai = 0; ai < 2; ++ai)
#pragma unroll
            for (int m = 0; m < 4; ++m) { const int row = row0 + ai * HALF + m * 16; const size_t off = (size_t)row * 4096 + col0; float s = 0.f;
                float q; { const f32x4 v = *(const f32x4*)(osq + (size_t)row * 32 + (second ? 16 : 0) + 4 * fq); q = (v[0] + v[1]) + (v[2] + v[3]); q += __shfl_xor(q, 16); q += __shfl_xor(q, 32); }
                const float rn = rsqrtf(q * (1.0f / 2048.0f) + RMS_EPS);
#pragma unroll
                for (int bj = 0; bj < 2; ++bj) { bf16_t* xp = xb + off + bj * HALF; f32x4 b0, b1; unpack8(__builtin_nontemporal_load((const u32x4*)xp), b0, b1);
                    const f32x4 v0 = acc[ai][bj][m][0] * rn + b0, v1 = acc[ai][bj][m][1] * rn + b1;
                    *(u32x4*)xp = pack8(v0, v1); if (second) s += sq4(v0) + sq4(v1); }
                if (second) { s += __shfl_xor(s, 16); s += __shfl_xor(s, 32); if (fq == 0) ssq[(size_t)row * 64 + u.pn * 4 + wc] = s; } }
    }
};

struct EpiSwiGLU {
    static constexpr bool PERM = true, AFTER_DRAIN = false;
    const float* ssq; bf16_t* act; int ldc; PG8_LAS unsigned char* rcache; int tagbase;
    __device__ __forceinline__ static float silu(float x) { return x * __builtin_amdgcn_rcpf(1.0f + __expf(-x)); }
    __device__ __forceinline__ void operator()(const f32x4 (&acc)[2][2][4][2], const Unit& u, int wr, int wc, int fr, int fq) const {
        const int row0 = u.pm * BM + wr * 64 + fr, col0 = u.pn * HALF + wc * 32 + 8 * fq;
        float rinv8[8]; row_rinv8<64>(rinv8, ssq, 1.0f / 4096.0f, row0, fr, fq, (PG8_LAS float*)(rcache + (wr * 4 + wc) * 528), tagbase + u.pm);
#pragma unroll
        for (int ai = 0; ai < 2; ++ai)
#pragma unroll
            for (int m = 0; m < 4; ++m) { const int row = row0 + ai * HALF + m * 16; const float rinv = rinv8[ai * 4 + m];
                const float c1 = -rinv * 1.4426950408889634f, c2 = rinv * rinv; float gg[8], ee[8];
#pragma unroll
                for (int e = 0; e < 8; ++e) { gg[e] = acc[ai][0][m][e >> 2][e & 3]; ee[e] = __builtin_amdgcn_exp2f(gg[e] * c1); }
#pragma unroll
                for (int e = 0; e < 8; ++e) ee[e] = __builtin_amdgcn_rcpf(1.0f + ee[e]);
                f32x4 h0, h1;
#pragma unroll
                for (int e = 0; e < 4; ++e) { h0[e] = ((gg[e] * acc[ai][1][m][0][e]) * c2) * ee[e]; h1[e] = ((gg[4 + e] * acc[ai][1][m][1][e]) * c2) * ee[4 + e]; }
                *(u32x4*)(act + (size_t)row * ldc + col0) = pack8(h0, h1); }
    }
};


struct EpiPartialF32 {
    static constexpr bool PERM = true, AFTER_DRAIN = false;
    float* part; int ldc; size_t slice_stride;
    __device__ __forceinline__ void operator()(const f32x4 (&acc)[2][2][4][2], const Unit& u, int wr, int wc, int fr, int fq) const {
        const int row0 = u.pm * BM + wr * 64 + fr, col0 = u.pn * BM + wc * 32 + 8 * fq; float* base = part + (size_t)u.ks * slice_stride;
#pragma unroll
        for (int ai = 0; ai < 2; ++ai)
#pragma unroll
            for (int m = 0; m < 4; ++m) { float* rowp = base + (size_t)(row0 + ai * HALF + m * 16) * ldc + col0;
#pragma unroll
                for (int bj = 0; bj < 2; ++bj) { *(f32x4*)(rowp + bj * HALF) = acc[ai][bj][m][0]; *(f32x4*)(rowp + bj * HALF + 4) = acc[ai][bj][m][1]; } }
    }
};
struct SplitKOrder {
    int nN, KS, nwg, G, c;
    __device__ void init(int M, int N, int KS_, int G_, int c_) { nN = N / BM; KS = KS_; nwg = (M / BM) * nN * KS; G = G_; c = c_; }
    __device__ bool next(int i, Unit& u) const { const long L = (long)i * G + c; if (L >= nwg) return false; const int per = nN * KS, id = (int)L; u.pm = id / per; const int r = id % per; u.pn = r / KS; u.ks = r % KS; return true; }
    __device__ __forceinline__ void a_ready(const Unit&) const {}
    __device__ __forceinline__ void done(const Unit&) const {}
};
template <class Epi, class Sched, bool ALIGN_EPI = false, bool SP2 = false>
__device__ __forceinline__ void gemm_phase(PG8_LAS unsigned char* lds, const Gemm g, const Sched& S, const Epi& E) {
    int tid_ = threadIdx.x; asm volatile("" : "+v"(tid_));
    const int tid = tid_, wid = __builtin_amdgcn_readfirstlane(tid >> 6), lane = tid & 63, wr = wid >> 2, wc = wid & 3, fr = lane & 15, fq = lane >> 4;
    const int K = g.K, nt = K / BK, LD = g.ld ? g.ld : K;
    unsigned voffA[2], voffB[2];
#pragma unroll
    for (int i = 0; i < 2; ++i) { int R, C; stage_rc(tid * 16 + i * 8192, R, C); const int Rb = Epi::PERM ? ((R & ~31) + perm32(R & 31)) : R;
        voffA[i] = (unsigned)(R * LD + C) * 2u; voffB[i] = (unsigned)(Rb * LD + C) * 2u; }
    const size_t kstep = (size_t)(BK * 2);
    const size_t hstep = (size_t)HALF * LD * 2;
    const size_t tstep = 2 * hstep;
    const unsigned ldsw = (unsigned)wid * 1024u;
    const int aoff = lds_byte(wr * 64 + fr, fq * 8), boff = lds_byte(wc * 32 + fr, fq * 8);
#define PG8_SA(b, h) (((b) * 2 + (h)) * HTB)
#define PG8_SB(b, h) ((4 + (b) * 2 + (h)) * HTB)
#define PG8_STAGE(bufoff, gbase, voff) do { _Pragma("unroll") for (int _i = 0; _i < 2; ++_i) \
        __builtin_amdgcn_global_load_lds((const unsigned*)((const char*)(gbase) + (voff)[_i]), (PG8_LAS unsigned*)(lds + (bufoff) + ldsw + _i * 8192), 16, 0, 0); } while (0)
#define PG8_LDA(dst, b, h) do { _Pragma("unroll") for (int m = 0; m < 4; ++m) _Pragma("unroll") for (int k = 0; k < 2; ++k) dst[m][k] = *(const PG8_LAS bf16x8*)(lds + PG8_SA(b, h) + aoff + m * 2048 + k * 1024); } while (0)
#define PG8_LDB(dst, b, h) do { _Pragma("unroll") for (int n = 0; n < 2; ++n) _Pragma("unroll") for (int k = 0; k < 2; ++k) dst[n][k] = *(const PG8_LAS bf16x8*)(lds + PG8_SB(b, h) + boff + n * 2048 + k * 1024); } while (0)
#define PG8_MMA(ai, bj, At, Bt) do { __builtin_amdgcn_s_setprio(1); _Pragma("unroll") for (int m = 0; m < 4; ++m) _Pragma("unroll") for (int n = 0; n < 2; ++n) _Pragma("unroll") for (int k = 0; k < 2; ++k) \
        acc[ai][bj][m][n] = __builtin_amdgcn_mfma_f32_16x16x32_bf16(Bt[n][k], At[m][k], acc[ai][bj][m][n], 0, 0, 0); __builtin_amdgcn_s_setprio(0); } while (0)
#define PG8_WAIT_V(n) asm volatile("s_waitcnt vmcnt(" #n ")" ::: "memory")
#define PG8_WAIT_L(n) asm volatile("s_waitcnt lgkmcnt(" #n ")" ::: "memory")
#define PG8_BAR __builtin_amdgcn_s_barrier()
#define PG8_SCHED __builtin_amdgcn_sched_barrier(0)
    Unit cur, nxt; int ui = 0;
    if (!S.next(0, cur)) return;
    f32x4 acc[2][2][4][2];
#pragma unroll
    for (int a = 0; a < 2; ++a)
#pragma unroll
        for (int b = 0; b < 2; ++b)
#pragma unroll
            for (int m = 0; m < 4; ++m)
#pragma unroll
                for (int n = 0; n < 2; ++n) acc[a][b][m][n] = (f32x4){0.f, 0.f, 0.f, 0.f};
    bf16x8 At[4][2], B0[2][2], B1[2][2];
    const char* cA = (const char*)g.A + (size_t)cur.pm * tstep + (size_t)cur.ks * K * 2; const char* cB = (const char*)g.Bt + (size_t)cur.pn * tstep + (size_t)cur.ks * K * 2;
    S.a_ready(cur);
    if constexpr (SP2) {
        PG8_STAGE(PG8_SB(0, 0), cB, voffB); PG8_STAGE(PG8_SB(0, 1), cB + hstep, voffB); PG8_STAGE(PG8_SA(0, 0), cA, voffA); PG8_STAGE(PG8_SA(0, 1), cA + hstep, voffA);
        if (wr == 1) PG8_BAR;
        PG8_WAIT_V(2); PG8_BAR;
        PG8_STAGE(PG8_SB(1, 0), cB + kstep, voffB); PG8_STAGE(PG8_SA(1, 0), cA + kstep, voffA); PG8_STAGE(PG8_SB(1, 1), cB + hstep + kstep, voffB);
        PG8_WAIT_V(6); PG8_BAR;
    } else {
        PG8_STAGE(PG8_SB(0, 0), cB, voffB); PG8_STAGE(PG8_SA(0, 0), cA, voffA); PG8_STAGE(PG8_SB(0, 1), cB + hstep, voffB); PG8_STAGE(PG8_SA(0, 1), cA + hstep, voffA);
        if (wr == 1) PG8_BAR;
        PG8_WAIT_V(4); PG8_BAR;
        PG8_STAGE(PG8_SB(1, 0), cB + kstep, voffB); PG8_STAGE(PG8_SA(1, 0), cA + kstep, voffA); PG8_STAGE(PG8_SB(1, 1), cB + hstep + kstep, voffB);
        PG8_WAIT_V(6); PG8_BAR;
    }
    for (;;) {
        const bool has_next = S.next(ui + 1, nxt);
        const char* nA = has_next ? (const char*)g.A + (size_t)nxt.pm * tstep + (size_t)nxt.ks * K * 2 : cA; const char* nB = has_next ? (const char*)g.Bt + (size_t)nxt.pn * tstep + (size_t)nxt.ks * K * 2 : cB;
        for (int t = 0; t < nt; t += 2) {
            const bool last = (t == nt - 2);
            const char* a1 = cA + (size_t)(t + 1) * kstep;
            const char* a2 = last ? nA : cA + (size_t)(t + 2) * kstep; const char* b2 = last ? nB : cB + (size_t)(t + 2) * kstep;
            const char* a3 = a2 + kstep; const char* b3 = b2 + kstep;
            if (last && has_next) S.a_ready(nxt);
            if constexpr (SP2) {
            PG8_LDB(B0, 0, 0); PG8_LDB(B1, 0, 1); PG8_SCHED; PG8_LDA(At, 0, 0); PG8_STAGE(PG8_SA(1, 1), a1 + hstep, voffA);
            PG8_WAIT_V(8); PG8_WAIT_L(0); PG8_BAR; PG8_MMA(0, 0, At, B0); PG8_MMA(0, 1, At, B1); PG8_BAR; PG8_SCHED;
            PG8_LDA(At, 0, 1); PG8_STAGE(PG8_SB(0, 0), b2, voffB); PG8_STAGE(PG8_SB(0, 1), b2 + hstep, voffB); PG8_STAGE(PG8_SA(0, 0), a2, voffA);
            PG8_WAIT_V(8); PG8_WAIT_L(0); PG8_BAR; PG8_MMA(1, 0, At, B0); PG8_MMA(1, 1, At, B1); PG8_BAR; PG8_SCHED;
            PG8_LDB(B0, 1, 0); PG8_LDB(B1, 1, 1); PG8_SCHED; PG8_LDA(At, 1, 0); PG8_STAGE(PG8_SA(0, 1), a2 + hstep, voffA);
            PG8_WAIT_V(8); PG8_WAIT_L(0); PG8_BAR; PG8_MMA(0, 0, At, B0); PG8_MMA(0, 1, At, B1); PG8_BAR; PG8_SCHED;
            PG8_LDA(At, 1, 1); PG8_STAGE(PG8_SB(1, 0), b3, voffB); PG8_STAGE(PG8_SB(1, 1), b3 + hstep, voffB); PG8_STAGE(PG8_SA(1, 0), a3, voffA);
            PG8_WAIT_V(8); PG8_WAIT_L(0); PG8_BAR; PG8_MMA(1, 0, At, B0); PG8_MMA(1, 1, At, B1); PG8_BAR; PG8_SCHED;
            } else {
            PG8_LDB(B0, 0, 0); PG8_SCHED; PG8_LDA(At, 0, 0); PG8_STAGE(PG8_SA(1, 1), a1 + hstep, voffA);
            PG8_WAIT_L(8); PG8_BAR; PG8_WAIT_L(0); PG8_MMA(0, 0, At, B0); PG8_BAR; PG8_SCHED;
            PG8_LDB(B1, 0, 1); PG8_STAGE(PG8_SB(0, 0), b2, voffB);
            PG8_BAR; PG8_WAIT_L(0); PG8_MMA(0, 1, At, B1); PG8_BAR;
            PG8_LDA(At, 0, 1); PG8_STAGE(PG8_SA(0, 0), a2, voffA);
            PG8_BAR; PG8_WAIT_L(0); PG8_MMA(1, 0, At, B0); PG8_BAR; PG8_SCHED;
            PG8_STAGE(PG8_SB(0, 1), b2 + hstep, voffB);
            PG8_WAIT_V(6); PG8_BAR; PG8_MMA(1, 1, At, B1); PG8_BAR;
            PG8_LDB(B0, 1, 0); PG8_SCHED; PG8_LDA(At, 1, 0); PG8_STAGE(PG8_SA(0, 1), a2 + hstep, voffA);
            PG8_WAIT_L(8); PG8_BAR; PG8_WAIT_L(0); PG8_MMA(0, 0, At, B0); PG8_BAR; PG8_SCHED;
            PG8_LDB(B1, 1, 1); PG8_STAGE(PG8_SB(1, 0), b3, voffB);
            PG8_BAR; PG8_WAIT_L(0); PG8_MMA(0, 1, At, B1); PG8_BAR;
            PG8_LDA(At, 1, 1); PG8_STAGE(PG8_SA(1, 0), a3, voffA);
            PG8_BAR; PG8_WAIT_L(0); PG8_MMA(1, 0, At, B0); PG8_BAR; PG8_SCHED;
            PG8_STAGE(PG8_SB(1, 1), b3 + hstep, voffB);
            PG8_WAIT_V(6); PG8_BAR; PG8_MMA(1, 1, At, B1); PG8_BAR;
            }
        }
        if constexpr (ALIGN_EPI) { if (wr == 0) PG8_BAR; }
        if constexpr (!Epi::AFTER_DRAIN) { E(acc, cur, wr, wc, fr, fq); S.done(cur); }
        if (!has_next) break;
#pragma unroll
        for (int a = 0; a < 2; ++a)
#pragma unroll
            for (int b = 0; b < 2; ++b)
#pragma unroll
                for (int m = 0; m < 4; ++m)
#pragma unroll
                    for (int n = 0; n < 2; ++n) acc[a][b][m][n] = (f32x4){0.f, 0.f, 0.f, 0.f};
        cur = nxt; cA = nA; cB = nB; ++ui;
        if constexpr (ALIGN_EPI) { if (wr == 1) PG8_BAR; }
    }
    PG8_WAIT_V(0);
    if constexpr (!ALIGN_EPI) { if (wr == 0) PG8_BAR; }
    PG8_BAR;
    if constexpr (Epi::AFTER_DRAIN) { E.fused(acc, cur, wr, wc, fr, fq, lds, wid, lane); S.done(cur); }
#undef PG8_SA
#undef PG8_SB
#undef PG8_STAGE
#undef PG8_LDA
#undef PG8_LDB
#undef PG8_MMA
#undef PG8_WAIT_V
#undef PG8_WAIT_L
#undef PG8_BAR
#undef PG8_SCHED
}
}
constexpr int NWAVES = 8;
constexpr int T = 8192, DM = 4096, SEQ = 2048, NBATCH = 4, MEMLEN = 256, TMEM = NBATCH * MEMLEN;
constexpr int QRANK = 1024, KVRANK = 512, NH = 16, QKD = 192, QUP_N = NH * QKD, KVUP_N = NH * 256;
constexpr int SBW = 2048, XW = 512, FF = 11008, IN_COLS = 7744, IN_PAD = 7936, DEPTH = 2;
constexpr int NPH = 11;
constexpr int N_PHASES = 1 + DEPTH * NPH;
#ifndef MK_PER_PHASE
#define MK_PER_PHASE 0
#define DBL_MASK 0
#endif

constexpr size_t MiB = 1u << 20;
constexpr size_t WS_CTL = 0, CTL_ZERO_BYTES = 1 * MiB;
constexpr size_t WL_IN = 0, WL_QUP = 62 * MiB, WL_KVUP = 68 * MiB, WL_OUT = 72 * MiB, WL_XQ = 104 * MiB, WL_XKV = 108 * MiB, WL_XO = 116 * MiB, WL_GU = 120 * MiB, WL_DN = 292 * MiB, WL_BYTES = 378 * MiB;
constexpr size_t WS_W = 2 * MiB;
constexpr size_t WS_XB = WS_W + DEPTH * WL_BYTES;
constexpr size_t WS_MEMB = WS_XB + 64 * MiB;
constexpr size_t WS_KVX = WS_MEMB + 8 * MiB;
constexpr size_t WS_QX = WS_KVX + 4 * MiB;
constexpr size_t WS_OX = WS_QX + 64 * MiB;
constexpr size_t WS_R1 = WS_OX + 8 * MiB;
constexpr size_t WS_CQ = WS_R1, WS_CKV = WS_CQ + 16 * MiB, WS_QSB = WS_CKV + 8 * MiB, WS_KSB = WS_QSB + 32 * MiB, WS_VSB = WS_KSB + 32 * MiB, WS_KR = WS_VSB + 32 * MiB;
constexpr size_t WS_QRAW = WS_KR + 2 * MiB, WS_KVRAW = WS_QRAW + 48 * MiB, WS_MIXED = WS_KVRAW + 64 * MiB;
constexpr size_t WS_R1_END = WS_MIXED + 64 * MiB;
constexpr size_t WS_ACT = WS_R1;
static_assert(WS_ACT + 172 * MiB <= WS_R1_END, "ACT fits in R1");
constexpr size_t WS_SSQX = WS_R1_END;
constexpr size_t WS_SSQCQ = WS_SSQX + 14 * MiB;
constexpr size_t WS_SSQCKV = WS_SSQCQ + 1 * MiB;
constexpr size_t WS_SSQMEM = WS_SSQCKV + 1 * MiB;
constexpr size_t WS_KRN = WS_SSQMEM + 1 * MiB;
constexpr size_t WS_SSQO = WS_KRN + 1 * MiB;
constexpr size_t WS_END = WS_SSQO + 1 * MiB;
constexpr int CW_TMO = 0, CW_CODE = 1, CW_BAR = 4096;
static_assert((CW_BAR + 3456) * 4 <= (int)CTL_ZERO_BYTES, "CTL words inside the memset region");

constexpr int RING_OFF = 0, RING_BYTES = 131072;
constexpr int LDSCTL_OFF = RING_BYTES, MISC_OFF = LDSCTL_OFF + 320;
constexpr int LDS_BYTES = 147456;
constexpr int RCACHE_OFF = MISC_OFF + 128;
constexpr int XCH_OFF = RCACHE_OFF + 8 * 528;
static_assert(XCH_OFF + 4096 <= LDS_BYTES && XCH_OFF % 16 == 0, "LDS map");
#define GAS __attribute__((address_space(1)))
#define LAS __attribute__((address_space(3)))
typedef unsigned short bf16;
typedef unsigned v4u __attribute__((ext_vector_type(4)));
typedef float f32x4 __attribute__((ext_vector_type(4)));
typedef short bf16x8 __attribute__((ext_vector_type(8)));
typedef GAS unsigned gu32;
typedef GAS unsigned long long gu64;
#define RLX_AGENT __ATOMIC_RELAXED, __HIP_MEMORY_SCOPE_AGENT
#define LDS_WAIT() asm volatile("s_waitcnt lgkmcnt(0)" ::: "memory")
#define VM_WAIT() asm volatile("s_waitcnt vmcnt(0)" ::: "memory")
__device__ __forceinline__ unsigned long long rt() { return __builtin_amdgcn_s_memrealtime(); }
__device__ __forceinline__ unsigned f2bf(float f) { unsigned u = __builtin_bit_cast(unsigned, f); return (u + 0x7fffu + ((u >> 16) & 1u)) >> 16; }
__device__ __forceinline__ unsigned pk2(float lo, float hi) { unsigned r; asm("v_cvt_pk_bf16_f32 %0, %1, %2" : "=v"(r) : "v"(lo), "v"(hi)); return r; }
#define XB_TMO      128
#define XB_XCNT(j)  (256  + 64 * (j))
#define XB_XSUB(j)  (1280 + 64 * (j))
#define XB_XGEN(j)  (2304 + 64 * (j))
#define XB_TOP      3328
#define XB_TOPGEN   3392
#define XCD_BAR_WORDS 3456
#define XB_SPIN_CAP (1u << 18)

__device__ __forceinline__ unsigned xb_ld(unsigned* p)              { return __hip_atomic_load(p, __ATOMIC_RELAXED, __HIP_MEMORY_SCOPE_AGENT); }
__device__ __forceinline__ unsigned xb_add(unsigned* p, unsigned v) { return __hip_atomic_fetch_add(p, v, __ATOMIC_RELAXED, __HIP_MEMORY_SCOPE_AGENT); }
__device__ __forceinline__ unsigned xb_xcc_id() { return (unsigned)__builtin_amdgcn_s_getreg((3 << 11) | 20) & 0xFu; }
#define XB_SPIN(cond, bar) do { unsigned _sp = 0; while (cond) { __builtin_amdgcn_s_sleep(1); \
    if ((++_sp & 255u) == 0u) { if (xb_ld(&(bar)[XB_TMO])) break; if (_sp > XB_SPIN_CAP) { atomicAdd(&(bar)[XB_TMO], 1u); break; } } } } while (0)

struct XcdBarrier {
    unsigned* bar; unsigned x;
    volatile LAS unsigned* st;
};

__device__ __forceinline__ XcdBarrier xcd_barrier_post(unsigned* bar, volatile LAS unsigned* st) {
    XcdBarrier b; b.bar = bar; b.x = xb_xcc_id(); b.st = st;
    if (threadIdx.x == 0) (void)xb_add(&bar[XB_XCNT(b.x)], 1u);
    return b;
}
__device__ __forceinline__ void xcd_barrier_complete(unsigned* bar, unsigned x, unsigned& nloc, unsigned& nx) {
    const unsigned G = gridDim.x * gridDim.y * gridDim.z;
    unsigned sum, cnt, mine, sp = 0u;
    for (;;) {
        sum = 0u; cnt = 0u; mine = 0u;
        unsigned cv[16];
#pragma unroll
        for (unsigned j = 0; j < 16; ++j) asm volatile("global_load_dword %0, %1, off sc1" : "=v"(cv[j]) : "v"(&bar[XB_XCNT(j)]) : "memory");
        asm volatile("s_waitcnt vmcnt(0)" : "+v"(cv[0]), "+v"(cv[1]), "+v"(cv[2]), "+v"(cv[3]), "+v"(cv[4]), "+v"(cv[5]), "+v"(cv[6]), "+v"(cv[7]) :: "memory");
        asm volatile("" : "+v"(cv[8]), "+v"(cv[9]), "+v"(cv[10]), "+v"(cv[11]), "+v"(cv[12]), "+v"(cv[13]), "+v"(cv[14]), "+v"(cv[15]));
#pragma unroll
        for (unsigned j = 0; j < 16; ++j) { const unsigned c = cv[j]; sum += c; cnt += (c > 0u) ? 1u : 0u; mine = (j == x) ? c : mine; }
        if (sum == G) break;
        __builtin_amdgcn_s_sleep(1);
        if ((++sp & 255u) == 0u) { if (xb_ld(&bar[XB_TMO])) break; if (sp > XB_SPIN_CAP) { atomicAdd(&bar[XB_TMO], 1u); break; } }
    }
    nloc = mine > 0u ? mine : 1u; nx = cnt > 0u ? cnt : 1u;
}

__device__ __forceinline__ void xcd_barrier(const XcdBarrier& b) {
    asm volatile("s_waitcnt vmcnt(0)" ::: "memory");
    __syncthreads();
    if (threadIdx.x == 0) {
        unsigned* bar = b.bar;
        __builtin_amdgcn_s_waitcnt(0);
        unsigned nloc = b.st[0], nx = b.st[1];
        if (nloc == 0u) { xcd_barrier_complete(bar, b.x, nloc, nx); b.st[0] = nloc; b.st[1] = nx; }
        const unsigned old = xb_add(&bar[XB_XSUB(b.x)], 1u);
        const unsigned gen = old / nloc;
        if (old + 1u == (gen + 1u) * nloc) {
            __builtin_amdgcn_fence(__ATOMIC_RELEASE, "agent");
            asm volatile("s_waitcnt vmcnt(0)" ::: "memory");
            const unsigned og = xb_add(&bar[XB_TOP], 1u);
            const unsigned tg = og / nx;
            if (og + 1u == (tg + 1u) * nx) xb_add(&bar[XB_TOPGEN], 1u);
            else XB_SPIN(xb_ld(&bar[XB_TOPGEN]) == tg, bar);
            __builtin_amdgcn_fence(__ATOMIC_ACQUIRE, "agent");
            xb_add(&bar[XB_XGEN(b.x)], 1u);
            asm volatile("s_waitcnt vmcnt(0)" ::: "memory");
        } else {
            XB_SPIN(xb_ld(&bar[XB_XGEN(b.x)]) == gen, bar);
            __builtin_amdgcn_fence(__ATOMIC_ACQUIRE, "agent");
            asm volatile("s_waitcnt vmcnt(0)" ::: "memory");
        }
    }
    __syncthreads();
}
typedef unsigned u32x2 __attribute__((ext_vector_type(2)));
__device__ __forceinline__ float wave_sum(float v) {
#pragma unroll
    for (int o = 1; o < 64; o <<= 1) v += __shfl_xor(v, o);
    return v;
}
__device__ __forceinline__ float wave_max(float v) {
#pragma unroll
    for (int o = 1; o < 64; o <<= 1) v = fmaxf(v, __shfl_xor(v, o));
    return v;
}
__device__ __forceinline__ float bf_lo(unsigned w) { return __uint_as_float(w << 16); }
__device__ __forceinline__ float bf_hi(unsigned w) { return __uint_as_float(w & 0xffff0000u); }
__device__ __forceinline__ float bf2f(bf16 h) { return __uint_as_float((unsigned)h << 16); }

#define CAS __attribute__((address_space(4)))
struct Args { const float* in[25]; float* out; unsigned char* ws; int ph_lo, ph_hi, li, pad; };
typedef const CAS Args* ArgsP;
__device__ __forceinline__ int local_tid() { int t = threadIdx.x; asm volatile("" : "+v"(t)); return t; }
__device__ __forceinline__ ArgsP phase_args() { ArgsP p = (ArgsP)__builtin_amdgcn_kernarg_segment_ptr(); asm volatile("" : "+s"(p)); return p; }
__device__ __forceinline__ float inv_freq_of(int i) { return exp2f(-(float)i * 0.4152410118609203f); }
__device__ __forceinline__ void rope_sincos(int pos, float inv_freq, float& sn, float& cs) {
    const float ang = (float)pos * inv_freq; double rv = (double)ang * 0.15915494309189535; rv -= rint(rv); const float fr = (float)rv;
    sn = __builtin_amdgcn_sinf(fr); cs = __builtin_amdgcn_cosf(fr);
}
namespace att {
typedef short bf16x8 __attribute__((ext_vector_type(8)));
typedef short s16x4 __attribute__((ext_vector_type(4)));
typedef float f32x16 __attribute__((ext_vector_type(16)));
typedef unsigned u32x4 __attribute__((ext_vector_type(4)));
constexpr int NW = 8, QBLK = 32, KVBLK = 64, QB = NW * QBLK;
constexpr int SHM_V = 16384, SHM_K = 16384, SHM_KR = 8192;
constexpr int OFF_V = 0, OFF_K = 2 * SHM_V, OFF_KR = OFF_K + 2 * SHM_K, OFF_WS = OFF_KR + 2 * SHM_KR, LDS_ATT = OFF_WS + NW * 256;
#define KSWZ(row, colB) ((row) * 256 + ((colB) ^ (((row) & 7) << 4)))
#define KRSWZ(row, colB) ((row) * 128 + ((colB) ^ ((((row) >> 1) & 7) << 4)))
__device__ __forceinline__ int v_st(int k, int c) { const int kk = (k & ~0xC) | ((k & 4) << 1) | ((k & 8) >> 1); return ((kk >> 3) * 4 + (c >> 5)) * 512 + ((kk & 7) * 32 + (c & 31)) * 2; }
__device__ __forceinline__ int v_rd_base(int lane) { return ((lane & 3) << 3) | (((lane >> 2) & 3) << 6) | (((lane >> 4) & 1) << 5) | (((lane >> 5) & 1) << 8); }
constexpr int v_rd_off(int d0, int ks, int half) { return d0 * 512 + ks * 4096 + half * 2048; }
__device__ __forceinline__ int crow(int r, int hi) { return (r & 3) + 8 * (r >> 2) + 4 * hi; }
__device__ __forceinline__ unsigned cvtpk(float lo, float hi) { unsigned r; asm volatile("v_cvt_pk_bf16_f32 %0, %1, %2" : "=v"(r) : "v"(lo), "v"(hi)); return r; }
#define ATT_SBAR() __builtin_amdgcn_sched_barrier(0)
#define ATT_PK4(P, B_, OUT) do { unsigned a0 = cvtpk(P[B_ + 0], P[B_ + 1]), a1 = cvtpk(P[B_ + 2], P[B_ + 3]); unsigned b0 = cvtpk(P[B_ + 4], P[B_ + 5]), b1 = cvtpk(P[B_ + 6], P[B_ + 7]); \
        auto r0 = __builtin_amdgcn_permlane32_swap(a0, b0, false, false); auto r1 = __builtin_amdgcn_permlane32_swap(a1, b1, false, false); \
        u32x4 w = {r0[0], r1[0], r0[1], r1[1]}; OUT = *reinterpret_cast<bf16x8*>(&w); } while (0)

template <int KB, int NQ>
__device__ __forceinline__ void qkt(f32x16& p0, f32x16& p1, LAS unsigned char* lds, int r32, int hi, const bf16x8* qr) {
    p0 = f32x16{}; p1 = f32x16{};
    LAS unsigned char* kb[4];
#pragma unroll
    for (int dd = 0; dd < 4; ++dd) kb[dd] = lds + OFF_K + KB * SHM_K + KSWZ(r32, (dd * 16 + hi * 8) * 2);
#pragma unroll
    for (int d0 = 0; d0 < 8; ++d0) { LAS unsigned char* a = kb[d0 & 3] + (d0 >> 2) * 128;
        const bf16x8 b0 = *(const LAS bf16x8*)a, b1 = *(const LAS bf16x8*)(a + 32 * 256);
        p0 = __builtin_amdgcn_mfma_f32_32x32x16_bf16(b0, qr[d0], p0, 0, 0, 0);
        p1 = __builtin_amdgcn_mfma_f32_32x32x16_bf16(b1, qr[d0], p1, 0, 0, 0); }
    if constexpr (NQ == 12) {
#pragma unroll
        for (int d0 = 0; d0 < 4; ++d0) { LAS unsigned char* a = lds + OFF_KR + KB * SHM_KR + KRSWZ(r32, (d0 * 16 + hi * 8) * 2);
            const bf16x8 b0 = *(const LAS bf16x8*)a, b1 = *(const LAS bf16x8*)(a + 32 * 128);
            p0 = __builtin_amdgcn_mfma_f32_32x32x16_bf16(b0, qr[8 + d0], p0, 0, 0, 0);
            p1 = __builtin_amdgcn_mfma_f32_32x32x16_bf16(b1, qr[8 + d0], p1, 0, 0, 0); } }
}
template <int VB>
__device__ __forceinline__ void pv_tile(f32x16* o, int vb0, bf16x8 pa0, bf16x8 pa1, bf16x8 pa2, bf16x8 pa3) {
#define ATT_TRRD(dst, off) asm volatile("ds_read_b64_tr_b16 %0, %1 offset:%2" : "=&v"(dst) : "v"(vb0), "i"(off) : "memory")
#define ATT_PV_D0(d0) do { s16x4 l0, l1, l2, l3, h0, h1, h2, h3; constexpr int b_ = OFF_V + VB * SHM_V + v_rd_off(d0, 0, 0); \
        ATT_TRRD(l0, b_); ATT_TRRD(h0, b_ + 2048); ATT_TRRD(l1, b_ + 4096); ATT_TRRD(h1, b_ + 6144); ATT_TRRD(l2, b_ + 8192); ATT_TRRD(h2, b_ + 10240); ATT_TRRD(l3, b_ + 12288); ATT_TRRD(h3, b_ + 14336); \
        asm volatile("s_waitcnt lgkmcnt(0)" ::: "memory"); ATT_SBAR(); \
        o[d0] = __builtin_amdgcn_mfma_f32_32x32x16_bf16((bf16x8){l0[0], l0[1], l0[2], l0[3], h0[0], h0[1], h0[2], h0[3]}, pa0, o[d0], 0, 0, 0); \
        o[d0] = __builtin_amdgcn_mfma_f32_32x32x16_bf16((bf16x8){l1[0], l1[1], l1[2], l1[3], h1[0], h1[1], h1[2], h1[3]}, pa1, o[d0], 0, 0, 0); \
        o[d0] = __builtin_amdgcn_mfma_f32_32x32x16_bf16((bf16x8){l2[0], l2[1], l2[2], l2[3], h2[0], h2[1], h2[2], h2[3]}, pa2, o[d0], 0, 0, 0); \
        o[d0] = __builtin_amdgcn_mfma_f32_32x32x16_bf16((bf16x8){l3[0], l3[1], l3[2], l3[3], h3[0], h3[1], h3[2], h3[3]}, pa3, o[d0], 0, 0, 0); } while (0)
    ATT_PV_D0(0); ATT_PV_D0(1); ATT_PV_D0(2); ATT_PV_D0(3);
#undef ATT_PV_D0
#undef ATT_TRRD
}


__device__ __forceinline__ void softmax_step(f32x16& p0, f32x16& p1, int kb, int qlo, int qpos, int hi, float scale, float& m_reg, float& l_reg, f32x16* o,
                                             bf16x8& pa0, bf16x8& pa1, bf16x8& pa2, bf16x8& pa3) {
    const float C2 = scale * 1.4426950408889634f;
    if (kb + KVBLK - 1 > qlo) {
        const int dq = qpos - kb - 4 * hi; const float NEG = -__builtin_inff();
#pragma unroll
        for (int r = 0; r < 16; ++r) { const int c = (r & 3) + 8 * (r >> 2); if (c > dq) p0[r] = NEG; if (c + 32 > dq) p1[r] = NEG; }
    }
    float pmax = p0[0];
#pragma unroll
    for (int r = 1; r < 16; ++r) pmax = fmaxf(pmax, p0[r]);
#pragma unroll
    for (int r = 0; r < 16; ++r) pmax = fmaxf(pmax, p1[r]);
    { auto rr = __builtin_amdgcn_permlane32_swap(__float_as_uint(pmax), __float_as_uint(pmax), false, false); pmax = fmaxf(__uint_as_float(rr[0]), __uint_as_float(rr[1])); }
    const float mn = fmaxf(m_reg, pmax), alpha = __builtin_amdgcn_exp2f((m_reg - mn) * C2), mnL = -mn * C2; m_reg = mn;
    float ps = 0.f;
#pragma unroll
    for (int r = 0; r < 16; ++r) { p0[r] = __builtin_amdgcn_exp2f(fmaf(p0[r], C2, mnL)); ps += p0[r]; }
#pragma unroll
    for (int r = 0; r < 16; ++r) { p1[r] = __builtin_amdgcn_exp2f(fmaf(p1[r], C2, mnL)); ps += p1[r]; }
    { auto rr = __builtin_amdgcn_permlane32_swap(__float_as_uint(ps), __float_as_uint(ps), false, false); ps = __uint_as_float(rr[0]) + __uint_as_float(rr[1]); }
    l_reg = l_reg * alpha + ps;
    if (__any(alpha < 1.f)) {
#pragma unroll
        for (int d = 0; d < 4; ++d)
#pragma unroll
            for (int r = 0; r < 16; ++r) o[d][r] *= alpha;
    }
    ATT_PK4(p0, 0, pa0); ATT_PK4(p0, 8, pa1); ATT_PK4(p1, 0, pa2); ATT_PK4(p1, 8, pa3);
}
__device__ __forceinline__ void sb_step(f32x16& p0, f32x16& p1, int kb, int qlo, int qpos, int hi, float scale, float& carry, bf16x8& pa0, bf16x8& pa1, bf16x8& pa2, bf16x8& pa3) {
    const float NC = -scale * 1.4426950408889634f;
    f32x16 k0, k1;
#pragma unroll
    for (int r = 0; r < 16; ++r) { const float t = __builtin_amdgcn_exp2f(fminf(fmaxf(p0[r] * NC, -115.f), 115.f)); const float b = __builtin_amdgcn_rcpf(1.0f + t); p0[r] = b; k0[r] = t * b; }
#pragma unroll
    for (int r = 0; r < 16; ++r) { const float t = __builtin_amdgcn_exp2f(fminf(fmaxf(p1[r] * NC, -115.f), 115.f)); const float b = __builtin_amdgcn_rcpf(1.0f + t); p1[r] = b; k1[r] = t * b; }
    if (kb + KVBLK - 1 >= qlo) {
        const int dq = qpos - kb - 4 * hi;
#pragma unroll
        for (int r = 0; r < 16; ++r) { const int c = (r & 3) + 8 * (r >> 2); if (!(c < dq)) { p0[r] = 0.f; k0[r] = 1.f; } if (!(c + 32 < dq)) { p1[r] = 0.f; k1[r] = 1.f; } }
    }
    float T[8], Hown[8];
#pragma unroll
    for (int g = 0; g < 4; ++g) { T[g] = (k0[4 * g] * k0[4 * g + 1]) * (k0[4 * g + 2] * k0[4 * g + 3]); T[4 + g] = (k1[4 * g] * k1[4 * g + 1]) * (k1[4 * g + 2] * k1[4 * g + 3]); }
    float H = carry;
#pragma unroll
    for (int g = 7; g >= 0; --g) { auto rr = __builtin_amdgcn_permlane32_swap(__float_as_uint(T[g]), __float_as_uint(T[g]), false, false);
        const float e0 = __uint_as_float(rr[0]), e1 = __uint_as_float(rr[1]);
        const float H0 = H * e1; Hown[g] = hi ? H : H0; H = H0 * e0; }
    carry = H;
#pragma unroll
    for (int g = 0; g < 4; ++g) {
        { const float c3 = Hown[g], c2 = c3 * k0[4 * g + 3], c1 = c2 * k0[4 * g + 2], c0 = c1 * k0[4 * g + 1]; p0[4 * g + 3] *= c3; p0[4 * g + 2] *= c2; p0[4 * g + 1] *= c1; p0[4 * g] *= c0; }
        { const float c3 = Hown[4 + g], c2 = c3 * k1[4 * g + 3], c1 = c2 * k1[4 * g + 2], c0 = c1 * k1[4 * g + 1]; p1[4 * g + 3] *= c3; p1[4 * g + 2] *= c2; p1[4 * g + 1] *= c1; p1[4 * g] *= c0; }
    }
    ATT_PK4(p0, 0, pa0); ATT_PK4(p0, 8, pa1); ATT_PK4(p1, 0, pa2); ATT_PK4(p1, 8, pa3);
}

template <int MODE>
__device__ __forceinline__ void attn_unit(LAS unsigned char* lds, const bf16* Q, int ldq, const bf16* K, int ldk, const bf16* KR, const bf16* V, int ldv, void* O_, int ldo, int P0, float scale,
                                          const float* gq = nullptr, const float* gk = nullptr, const float* ssqx = nullptr, const int* posq = nullptr, float* osq = nullptr) {
    constexpr int NQ = (MODE == 0) ? 12 : 8;
    const int tid = local_tid(), wid = __builtin_amdgcn_readfirstlane(tid >> 6), lane = tid & 63, r32 = lane & 31, hi = lane >> 5;
    const int NT = (MODE == 1) ? 4 : P0 / KVBLK + 4;
    const int qlo = (MODE == 1) ? (1 << 28) : P0 + wid * QBLK, qpos = qlo + r32;
    if (wid >= 4) __builtin_amdgcn_s_setprio(1);
    float gkv[8];
    if constexpr (MODE == 1) { const GAS f32x4* gp = (const GAS f32x4*)(gk + (tid & 15) * 8); const f32x4 g0 = gp[0], g1 = gp[1];
#pragma unroll
        for (int j = 0; j < 4; ++j) { gkv[j] = g0[j]; gkv[4 + j] = g1[j]; } }
    const int sr = tid >> 4, sc = (tid & 15) * 8, kws = KSWZ(sr, sc * 2), vst0 = v_st(sr, sc), vst1 = v_st(32 + sr, sc);
    const int krr = tid >> 3, krc = (tid & 7) * 8, krws = KRSWZ(krr, krc * 2);
    const int vb0 = (int)(size_t)lds + v_rd_base(lane);
    bf16x8 st_k0, st_k1, st_v0, st_v1, st_kr;
#define ATT_LOAD(kb) do { st_k0 = *(const GAS bf16x8*)(K + (size_t)((kb) + sr) * ldk + sc); st_k1 = *(const GAS bf16x8*)(K + (size_t)((kb) + 32 + sr) * ldk + sc); \
        st_v0 = *(const GAS bf16x8*)(V + (size_t)((kb) + sr) * ldv + sc); st_v1 = *(const GAS bf16x8*)(V + (size_t)((kb) + 32 + sr) * ldv + sc); \
        if constexpr (MODE == 0) st_kr = *(const GAS bf16x8*)(KR + (size_t)((kb) + krr) * 64 + krc); } while (0)
#define ATT_WRITE(bf) do { *(LAS bf16x8*)(lds + OFF_K + (bf) * SHM_K + kws) = st_k0; *(LAS bf16x8*)(lds + OFF_K + (bf) * SHM_K + kws + 32 * 256) = st_k1; \
        *(LAS bf16x8*)(lds + OFF_V + (bf) * SHM_V + vst0) = st_v0; *(LAS bf16x8*)(lds + OFF_V + (bf) * SHM_V + vst1) = st_v1; \
        if constexpr (MODE == 0) *(LAS bf16x8*)(lds + OFF_KR + (bf) * SHM_KR + krws) = st_kr; } while (0)
#define ATT_KNORM1(S_) do { float v_[8], ss_ = 0.f; _Pragma("unroll") for (int j = 0; j < 8; ++j) { v_[j] = bf2f((bf16)S_[j]); ss_ += v_[j] * v_[j]; } \
        ss_ += __shfl_xor(ss_, 1); ss_ += __shfl_xor(ss_, 2); ss_ += __shfl_xor(ss_, 4); ss_ += __shfl_xor(ss_, 8);        \
        const float ri_ = rsqrtf(ss_ * (1.0f / 128.0f) + 1e-6f); _Pragma("unroll") for (int j = 0; j < 8; ++j) v_[j] *= ri_ * gkv[j]; \
        u32x4 w_ = {cvtpk(v_[0], v_[1]), cvtpk(v_[2], v_[3]), cvtpk(v_[4], v_[5]), cvtpk(v_[6], v_[7])}; S_ = *reinterpret_cast<bf16x8*>(&w_); } while (0)
#define ATT_KNORM() do { if constexpr (MODE == 1) { ATT_KNORM1(st_k0); ATT_KNORM1(st_k1); } } while (0)
#define ATT_KB(t) (((MODE == 2) ? (NT - 1 - (t)) : (t)) * KVBLK)
    ATT_LOAD(ATT_KB(0));
    bf16x8 qr[NQ];
    if constexpr (MODE != 1) { const bf16* qrow = Q + (size_t)(wid * QBLK + r32) * ldq;
#pragma unroll
      for (int d0 = 0; d0 < NQ; ++d0) qr[d0] = *(const GAS bf16x8*)(qrow + d0 * 16 + hi * 8); }
    else if (wid < 4) {
        const GAS float* qrow = (const GAS float*)Q + (size_t)(wid * QBLK + r32) * ldq; f32x4 qa[8][2];
#pragma unroll
        for (int d0 = 0; d0 < 8; ++d0) { const GAS f32x4* p = (const GAS f32x4*)(qrow + d0 * 16 + hi * 8); qa[d0][0] = p[0]; qa[d0][1] = p[1]; }
#pragma unroll
        for (int ks = 1; ks < 4; ++ks)
#pragma unroll
            for (int d0 = 0; d0 < 8; ++d0) { const GAS f32x4* p = (const GAS f32x4*)(qrow + (size_t)ks * T * XW + d0 * 16 + hi * 8); qa[d0][0] += p[0]; qa[d0][1] += p[1]; }
        f32x4 gx[8][2];
#pragma unroll
        for (int d0 = 0; d0 < 8; ++d0) { const GAS f32x4* gp = (const GAS f32x4*)(gq + d0 * 16 + hi * 8); gx[d0][0] = gp[0]; gx[d0][1] = gp[1]; }
        float sx = 0.f;
        { const GAS f32x4* sp = (const GAS f32x4*)(ssqx + (size_t)(wid * QBLK + r32) * 64 + hi * 32);
#pragma unroll
          for (int i = 0; i < 8; ++i) { const f32x4 v = sp[i]; sx += (v[0] + v[1]) + (v[2] + v[3]); } }
        { auto rr = __builtin_amdgcn_permlane32_swap(__float_as_uint(sx), __float_as_uint(sx), false, false); sx = __uint_as_float(rr[0]) + __uint_as_float(rr[1]); }
        const float rx = rsqrtf(sx * (1.0f / 4096.0f) + 1e-6f);
        float ss = 0.f;
#pragma unroll
        for (int d0 = 0; d0 < 8; ++d0) { qa[d0][0] *= rx; qa[d0][1] *= rx; ss += ((qa[d0][0][0] * qa[d0][0][0] + qa[d0][0][1] * qa[d0][0][1]) + (qa[d0][0][2] * qa[d0][0][2] + qa[d0][0][3] * qa[d0][0][3]))
                                                                                 + ((qa[d0][1][0] * qa[d0][1][0] + qa[d0][1][1] * qa[d0][1][1]) + (qa[d0][1][2] * qa[d0][1][2] + qa[d0][1][3] * qa[d0][1][3])); }
        { auto rr = __builtin_amdgcn_permlane32_swap(__float_as_uint(ss), __float_as_uint(ss), false, false); ss = __uint_as_float(rr[0]) + __uint_as_float(rr[1]); }
        const float ri = rsqrtf(ss * (1.0f / 128.0f) + 1e-6f);
#pragma unroll
        for (int d0 = 0; d0 < 8; ++d0) { const f32x4 v0 = qa[d0][0] * ri * gx[d0][0], v1 = qa[d0][1] * ri * gx[d0][1];
            u32x4 w = {cvtpk(v0[0], v0[1]), cvtpk(v0[2], v0[3]), cvtpk(v1[0], v1[1]), cvtpk(v1[2], v1[3])}; qr[d0] = *reinterpret_cast<bf16x8*>(&w); }
    }
    if constexpr (MODE == 0) {
        f32x4 gn[8][2], gr[2][4];
#pragma unroll
        for (int d0 = 0; d0 < 8; ++d0) { const GAS f32x4* gp = (const GAS f32x4*)(gq + d0 * 16 + hi * 8); gn[d0][0] = gp[0]; gn[d0][1] = gp[1]; }
#pragma unroll
        for (int dd = 0; dd < 2; ++dd) { const int i0 = 16 * dd + 8 * hi; const GAS f32x4* g1p = (const GAS f32x4*)(gq + 128 + i0); const GAS f32x4* g2p = (const GAS f32x4*)(gq + 160 + i0);
            gr[dd][0] = g1p[0]; gr[dd][1] = g1p[1]; gr[dd][2] = g2p[0]; gr[dd][3] = g2p[1]; }
        int pos = posq[wid * QBLK + r32];
        float sn_ = 0.f, sr_ = 0.f;
#pragma unroll
        for (int d0 = 0; d0 < 12; ++d0)
#pragma unroll
            for (int j = 0; j < 8; ++j) { const float v = bf2f((bf16)qr[d0][j]); if (d0 < 8) sn_ += v * v; else sr_ += v * v; }
        { auto rr = __builtin_amdgcn_permlane32_swap(__float_as_uint(sn_), __float_as_uint(sn_), false, false); sn_ = __uint_as_float(rr[0]) + __uint_as_float(rr[1]); }
        { auto rr = __builtin_amdgcn_permlane32_swap(__float_as_uint(sr_), __float_as_uint(sr_), false, false); sr_ = __uint_as_float(rr[0]) + __uint_as_float(rr[1]); }
        asm volatile("" : "+v"(pos));
        const float rn = rsqrtf(sn_ * (1.0f / 128.0f) + 1e-6f), rr_ = rsqrtf(sr_ * (1.0f / 64.0f) + 1e-6f);
#pragma unroll
        for (int d0 = 0; d0 < 8; ++d0) { const f32x4 g0 = gn[d0][0], g1 = gn[d0][1]; float v[8];
#pragma unroll
            for (int j = 0; j < 8; ++j) v[j] = bf2f((bf16)qr[d0][j]) * rn * (j < 4 ? g0[j] : g1[j - 4]);
            u32x4 w = {cvtpk(v[0], v[1]), cvtpk(v[2], v[3]), cvtpk(v[4], v[5]), cvtpk(v[6], v[7])}; qr[d0] = *reinterpret_cast<bf16x8*>(&w); }
#pragma unroll
        for (int dd = 0; dd < 2; ++dd) { const int i0 = 16 * dd + 8 * hi; float o1[8], o2[8];
            const f32x4 ga0 = gr[dd][0], ga1 = gr[dd][1], gb0 = gr[dd][2], gb1 = gr[dd][3];
#pragma unroll
            for (int j = 0; j < 8; ++j) { float sn, cs; rope_sincos(pos, inv_freq_of(i0 + j), sn, cs);
                const float x1 = bf2f((bf16)qr[8 + dd][j]) * rr_ * (j < 4 ? ga0[j] : ga1[j - 4]), x2 = bf2f((bf16)qr[10 + dd][j]) * rr_ * (j < 4 ? gb0[j] : gb1[j - 4]);
                o1[j] = x1 * cs - x2 * sn; o2[j] = x1 * sn + x2 * cs; }
            u32x4 w1 = {cvtpk(o1[0], o1[1]), cvtpk(o1[2], o1[3]), cvtpk(o1[4], o1[5]), cvtpk(o1[6], o1[7])}; qr[8 + dd] = *reinterpret_cast<bf16x8*>(&w1);
            u32x4 w2 = {cvtpk(o2[0], o2[1]), cvtpk(o2[2], o2[3]), cvtpk(o2[4], o2[5]), cvtpk(o2[6], o2[7])}; qr[10 + dd] = *reinterpret_cast<bf16x8*>(&w2); }
    }
    float m_reg = -1e30f, l_reg = 0.f, carry = 1.f; f32x16 o[4] = {};
    f32x16 p0, p1; bf16x8 pa0, pa1, pa2, pa3;
    asm volatile("s_waitcnt vmcnt(0)" ::: "memory"); ATT_KNORM(); ATT_WRITE(0);
    __syncthreads();
#define ATT_STEP(t, BF) do { const int kb_ = ATT_KB(t); const bool more_ = (t) + 1 < NT; \
        if (more_) ATT_LOAD(ATT_KB((t) + 1)); \
        if ((MODE != 1 || wid < 4) && kb_ <= qlo + QBLK - 1) {                   \
            ATT_SBAR(); qkt<BF, NQ>(p0, p1, lds, r32, hi, qr); \
            if constexpr (MODE != 2) softmax_step(p0, p1, kb_, qlo, qpos, hi, scale, m_reg, l_reg, o, pa0, pa1, pa2, pa3); \
            else sb_step(p0, p1, kb_, qlo, qpos, hi, scale, carry, pa0, pa1, pa2, pa3); \
            ATT_SBAR(); pv_tile<BF>(o, vb0, pa0, pa1, pa2, pa3); } \
        if (more_) { asm volatile("s_waitcnt vmcnt(0)" ::: "memory"); ATT_KNORM(); ATT_WRITE((BF) ^ 1); } \
        if constexpr (MODE == 2) { if (lane == 0) xflag[(BF) * 8 + wid] = __all(carry == 0.f) ? 1u : 0u; }     \
        __syncthreads(); \
        if constexpr (MODE == 2) { stop_ = __all(xflag[(BF) * 8 + (lane & 7)] != 0u); } } while (0)
    LAS unsigned* xflag = (LAS unsigned*)(lds + LDS_ATT); bool stop_ = false;
    for (int t = 0; t < NT; t += 2) { ATT_STEP(t, 0); if (stop_) break; ATT_STEP(t + 1, 1); if (stop_) break; }
    if (MODE != 1 || wid < 4) { float rl = 1.0f; if constexpr (MODE != 2) rl = __builtin_amdgcn_rcpf(l_reg);
      float sq = 0.f; bf16* orow = (bf16*)O_ + (size_t)(wid * QBLK + r32) * ldo + hi * 8;
#pragma unroll
      for (int d0 = 0; d0 < 4; ++d0)
#pragma unroll
          for (int gp = 0; gp < 2; ++gp) { float a[4], b[4];
#pragma unroll
              for (int i = 0; i < 4; ++i) { a[i] = o[d0][8 * gp + i] * rl; b[i] = o[d0][8 * gp + 4 + i] * rl; sq += a[i] * a[i] + b[i] * b[i]; }
              const unsigned ax = cvtpk(a[0], a[1]), ay = cvtpk(a[2], a[3]), bx = cvtpk(b[0], b[1]), by = cvtpk(b[2], b[3]);
              auto rx = __builtin_amdgcn_permlane32_swap(ax, bx, false, false); auto ry = __builtin_amdgcn_permlane32_swap(ay, by, false, false);
              u32x4 w = {rx[0], ry[0], rx[1], ry[1]};
              *(GAS u32x4*)(orow + d0 * 32 + gp * 16) = w; }
      if constexpr (MODE != 1) { auto rr = __builtin_amdgcn_permlane32_swap(__float_as_uint(sq), __float_as_uint(sq), false, false); sq = __uint_as_float(rr[0]) + __uint_as_float(rr[1]);
          if (hi == 0) osq[(size_t)(wid * QBLK + r32) * 32] = sq; } }
    __syncthreads();
    __builtin_amdgcn_s_setprio(0);
#undef ATT_STEP
#undef ATT_KB
#undef ATT_KNORM
#undef ATT_KNORM1
#undef ATT_WRITE
#undef ATT_LOAD
}
}

__device__ __forceinline__ void p_attn_mfma(ArgsP P, int l, LAS unsigned char* lds) {
    unsigned char* ws = P->ws; const int G = gridDim.x;
    bf16* Ob = (bf16*)(ws + WS_MIXED); float* Osq = (float*)(ws + WS_SSQO);
    const float* gq = P->in[9] + l * QKD; const float* gk = P->in[10] + l * QKD; const int* pos = (const int*)P->in[2];
    for (int it = blockIdx.x; it < 256; it += G)
        for (int pass = 0; pass < 2; ++pass) {
            const int bh = it >> 2, pr = it & 3, b = bh >> 4, h = bh & 15, qb = pass ? 7 - pr : pr; const size_t row0 = (size_t)b * SEQ + qb * 256, key0 = (size_t)b * SEQ;
            att::attn_unit<0>(lds, (const bf16*)(ws + WS_QRAW) + row0 * QUP_N + h * QKD, QUP_N, (const bf16*)(ws + WS_KVRAW) + key0 * KVUP_N + h * 256, KVUP_N, (const bf16*)(ws + WS_KRN) + key0 * 64,
                              (const bf16*)(ws + WS_KVRAW) + key0 * KVUP_N + h * 256 + 128, KVUP_N, Ob + row0 * DM + h * 128, DM, qb * 256, 0.07216878364870322f, gq, gk, nullptr, pos + row0, Osq + row0 * 32 + h);
        }
    for (int it = blockIdx.x; it < 256; it += G)
        for (int pass = 0; pass < 2; ++pass) {
            const int bh = it >> 2, pr = it & 3, b = bh >> 4, h = bh & 15, qb = pass ? 7 - pr : pr; const size_t row0 = (size_t)b * SEQ + qb * 256, key0 = (size_t)b * SEQ;
            att::attn_unit<2>(lds, (const bf16*)(ws + WS_QSB) + row0 * SBW + h * 128, SBW, (const bf16*)(ws + WS_KSB) + key0 * SBW + h * 128, SBW, nullptr,
                              (const bf16*)(ws + WS_VSB) + key0 * SBW + h * 128, SBW, Ob + row0 * DM + 2048 + h * 128, DM, qb * 256, 0.08838834764831845f, nullptr, nullptr, nullptr, nullptr, Osq + row0 * 32 + 16 + h);
        }
}

__device__ __forceinline__ void p_xattn_mfma(ArgsP P, int l, LAS unsigned char* lds) {
    unsigned char* ws = P->ws; const int G = gridDim.x; const float* gq = P->in[18] + l * 128; const float* gk = P->in[19] + l * 128;
    for (int it = blockIdx.x; it < 256; it += G) {
        const int bh = it >> 4, qb = (it >> 1) & 7, b = bh >> 2, h = bh & 3; const size_t row0 = (size_t)b * SEQ + qb * 256 + (it & 1) * 128;
        const bf16* KV = (const bf16*)(ws + WS_KVX) + (size_t)l * TMEM * 1024 + (size_t)b * MEMLEN * 1024 + h * 256;
        att::attn_unit<1>(lds, (const bf16*)((const float*)(ws + WS_QX) + row0 * XW + h * 128), XW, KV, 1024, nullptr, KV + 128, 1024, (bf16*)(ws + WS_OX) + row0 * XW + h * 128, XW, 0, 0.08838834764831845f, gq, gk,
                          (const float*)(ws + WS_SSQX) + ((size_t)(l * 3 + 1) * T + row0) * 64);
    }
}


struct TrD { const float* W; const float* g; bf16* WT; size_t ldk; int N, d0, kdst0, k0, n0; };
__device__ __forceinline__ void tr_dma_item(const TrD& D, LAS unsigned char* buf, int lane) {
    const char* gb = (const char*)(D.W + (size_t)D.k0 * D.N + D.n0);
    const unsigned rowoff = (unsigned)(lane >> 4) * (unsigned)D.N * 4u;
#pragma unroll
    for (int q = 0; q < 16; ++q) { const unsigned lo = rowoff + (unsigned)(((lane & 15) ^ ((q >> 1) & 7)) << 4);
        __builtin_amdgcn_global_load_lds((const unsigned*)(gb + (size_t)(4 * q) * D.N * 4 + lo), (LAS unsigned*)(buf + q * 1024), 16, 0, 2); }
    const int c = lane & 7, nr = lane >> 3;
    f32x4 ga = {1.f, 1.f, 1.f, 1.f}, gb4 = {1.f, 1.f, 1.f, 1.f};
    if (D.g) { ga = *(const GAS f32x4*)(D.g + D.k0 + 8 * c); gb4 = *(const GAS f32x4*)(D.g + D.k0 + 8 * c + 4); }
    asm volatile("s_waitcnt vmcnt(0)" ::: "memory");
    const int a0 = (int)(size_t)buf + 8 * c * 256 + (nr & 3) * 4, ce = c ^ (nr >> 2);
#pragma unroll
    for (int jj = 0; jj < 8; ++jj) { const int n = nr + 8 * jj; const LAS float* p = (const LAS float*)(size_t)(unsigned)(a0 + (((2 * jj) ^ ce) << 4));
        const float v0 = p[0] * ga[0], v1 = p[64] * ga[1], v2 = p[128] * ga[2], v3 = p[192] * ga[3], v4 = p[256] * gb4[0], v5 = p[320] * gb4[1], v6 = p[384] * gb4[2], v7 = p[448] * gb4[3];
        v4u o; o.x = pk2(v0, v1); o.y = pk2(v2, v3); o.z = pk2(v4, v5); o.w = pk2(v6, v7);
        *(GAS v4u*)(D.WT + (size_t)(D.d0 + n) * D.ldk + D.kdst0 + 8 * c) = o; }
    LDS_WAIT(); asm volatile("" ::: "memory");
}
template <int MAP>
__device__ __forceinline__ void tr_set(TrD& D, const float* W, int K, int N, const float* g, bf16* WT, size_t ldk, int kdst_off, int r) {
    const int nblk = N / 64, kb = (r & 3) + 4 * (r / (4 * nblk)), nb = (r >> 2) % nblk, k0 = 64 * kb, n0 = 64 * nb;
    int d0 = n0;
    if (MAP == 1) d0 = (n0 < 1536) ? n0 : (n0 < 1600 ? 7680 + (n0 - 1536) : n0 - 64);
    if (MAP == 2) d0 = (n0 >> 7) * 256 + (n0 & 127);
    if (MAP == 3) d0 = (n0 >> 7) * 256 + 128 + (n0 & 127);
    D.W = W; D.g = g; D.WT = WT; D.ldk = ldk; D.N = N; D.d0 = d0; D.kdst0 = kdst_off + k0; D.k0 = k0; D.n0 = n0;
}
__device__ __forceinline__ void row_to_bf16_ssq(const float* xrow, bf16* orow, float* ssq64, int lane) {
    const GAS f32x4* xr = (const GAS f32x4*)xrow + lane; GAS u32x2* o8 = (GAS u32x2*)orow + lane; float s = 0.f;
#pragma unroll 16
    for (int j = 0; j < 16; ++j) { const f32x4 v = xr[64 * j]; s += (v.x * v.x + v.y * v.y) + (v.z * v.z + v.w * v.w); u32x2 w; w.x = pk2(v.x, v.y); w.y = pk2(v.z, v.w); o8[64 * j] = w; }
    ssq64[lane] = s;
}
constexpr int I_IN = (DM / 64) * (IN_COLS / 64), I_QUP = (QRANK / 64) * (QUP_N / 64), I_KVUP = (KVRANK / 64) * (KVUP_N / 64), I_OUTH = (2048 / 64) * (DM / 64);
constexpr int I_XQ = (DM / 64) * (XW / 64), I_XKV = (DM / 64) * (1024 / 64), I_XO = (XW / 64) * (DM / 64), I_G = (DM / 64) * (FF / 64), I_DN = (FF / 64) * (DM / 64);
constexpr int I_LAYER = I_IN + I_QUP + I_KVUP + 2 * I_OUTH + I_XQ + I_XKV + I_XO + 2 * I_G + I_DN;
constexpr int I_XKV0 = I_IN + I_QUP + I_KVUP + 2 * I_OUTH + I_XQ;
__device__ __forceinline__ void conv_items(ArgsP P, LAS unsigned char* lds, int a0, int a1, int b0, int b1) {
    const int tid = local_tid(), lane = tid & 63, wave = __builtin_amdgcn_readfirstlane(tid >> 6), gw = blockIdx.x * NWAVES + wave, NGW = gridDim.x * NWAVES;
    unsigned char* ws = P->ws; const int n0 = a1 - a0, ntot = n0 + (b1 - b0);
    auto desc = [&](int v, TrD& D) { const int it = v < n0 ? a0 + v : b0 + (v - n0);
        const int l = it / I_LAYER; int r = it % I_LAYER; unsigned char* wl = ws + WS_W + (size_t)l * WL_BYTES;
        if (r < I_IN) { tr_set<1>(D, P->in[4] + (size_t)l * DM * IN_COLS, DM, IN_COLS, P->in[3] + l * DM, (bf16*)(wl + WL_IN), DM, 0, r); return; } r -= I_IN;
        if (r < I_QUP) { tr_set<0>(D, P->in[7] + (size_t)l * QRANK * QUP_N, QRANK, QUP_N, P->in[5] + l * QRANK, (bf16*)(wl + WL_QUP), QRANK, 0, r); return; } r -= I_QUP;
        if (r < I_KVUP) { tr_set<0>(D, P->in[8] + (size_t)l * KVRANK * KVUP_N, KVRANK, KVUP_N, P->in[6] + l * KVRANK, (bf16*)(wl + WL_KVUP), KVRANK, 0, r); return; } r -= I_KVUP;
        if (r < I_OUTH) { tr_set<0>(D, P->in[13] + (size_t)l * DM * DM, 2048, DM, P->in[11] + l * 2048, (bf16*)(wl + WL_OUT), DM, 0, r); return; } r -= I_OUTH;
        if (r < I_OUTH) { tr_set<0>(D, P->in[13] + (size_t)l * DM * DM + (size_t)2048 * DM, 2048, DM, P->in[12] + l * 2048, (bf16*)(wl + WL_OUT), DM, 2048, r); return; } r -= I_OUTH;
        if (r < I_XQ) { tr_set<0>(D, P->in[16] + (size_t)l * DM * XW, DM, XW, P->in[14] + l * DM, (bf16*)(wl + WL_XQ), DM, 0, r); return; } r -= I_XQ;
        if (r < I_XKV) { tr_set<0>(D, P->in[17] + (size_t)l * DM * 1024, DM, 1024, P->in[15] + l * DM, (bf16*)(wl + WL_XKV), DM, 0, r); return; } r -= I_XKV;
        if (r < I_XO) { tr_set<0>(D, P->in[20] + (size_t)l * XW * DM, XW, DM, nullptr, (bf16*)(wl + WL_XO), XW, 0, r); return; } r -= I_XO;
        if (r < I_G) { tr_set<2>(D, P->in[22] + (size_t)l * DM * FF, DM, FF, P->in[21] + l * DM, (bf16*)(wl + WL_GU), DM, 0, r); return; } r -= I_G;
        if (r < I_G) { tr_set<3>(D, P->in[23] + (size_t)l * DM * FF, DM, FF, P->in[21] + l * DM, (bf16*)(wl + WL_GU), DM, 0, r); return; } r -= I_G;
        tr_set<0>(D, P->in[24] + (size_t)l * FF * DM, FF, DM, nullptr, (bf16*)(wl + WL_DN), FF, 0, r);
    };
    LAS unsigned char* buf = lds + RING_OFF + wave * 16384;
    for (int v = gw; v < ntot; v += NGW) { TrD D; desc(v, D); tr_dma_item(D, buf, lane); }
}
__device__ __forceinline__ void p0_prologue(ArgsP P, LAS unsigned char* lds) {
    conv_items(P, lds, 0, I_IN, I_XKV0, I_XKV0 + I_XKV);
    const int tid = local_tid(), lane = tid & 63, wave = __builtin_amdgcn_readfirstlane(tid >> 6), gw = blockIdx.x * NWAVES + wave, NGW = gridDim.x * NWAVES;
    unsigned char* ws = P->ws;
    for (int c = gw * 64 + lane; c < DEPTH * 98304; c += NGW * 64) { const int l = c / 98304, cc = c % 98304;
        *(GAS v4u*)(ws + WS_W + (size_t)l * WL_BYTES + WL_IN + (size_t)IN_COLS * DM * 2 + (size_t)cc * 16) = (v4u){0u, 0u, 0u, 0u}; }
    for (int m = gw; m < T + TMEM; m += NGW) {
        if (m < T) row_to_bf16_ssq(P->in[0] + (size_t)m * DM, (bf16*)(ws + WS_XB) + (size_t)m * DM, (float*)(ws + WS_SSQX) + (size_t)m * 64, lane);
        else { const int mm = m - T; row_to_bf16_ssq(P->in[1] + (size_t)mm * DM, (bf16*)(ws + WS_MEMB) + (size_t)mm * DM, (float*)(ws + WS_SSQMEM) + (size_t)mm * 64, lane); }
    }
}

__device__ __forceinline__ void p_krn(ArgsP P, int l) {
    const int tid = local_tid(), lane = tid & 63, wave = __builtin_amdgcn_readfirstlane(tid >> 6), gw = blockIdx.x * NWAVES + wave, NGW = gridDim.x * NWAVES;
    unsigned char* ws = P->ws; const float* KR = (const float*)(ws + WS_KR); const int* pos = (const int*)P->in[2];
    const float gkr = (P->in[10] + l * QKD)[128 + lane], inv_freq = inv_freq_of(lane & 31);
    for (int row = gw; row < T; row += NGW) {
        float sn, cs; rope_sincos(pos[row], inv_freq, sn, cs);
        const float v = KR[(size_t)row * 64 + lane]; const float ss = wave_sum(v * v); const float r = v * rsqrtf(ss * (1.0f / 64.0f) + 1e-6f) * gkr; const float pr = __shfl_xor(r, 32);
        const float krv = (lane < 32) ? r * cs - pr * sn : pr * sn + r * cs;
        ((bf16*)(ws + WS_KRN))[(size_t)row * 64 + lane] = (unsigned short)f2bf(krv);
    }
}
#ifndef DBL_MASK
#define DBL_MASK 0
#endif
#define REP(k) for (int rep_ = 0; rep_ < 1 + (((DBL_MASK) >> (k)) & 1); ++rep_)
#ifndef PH_MASK
#define PH_MASK 0xFFF
#endif
#define EN(k) (((PH_MASK) >> (k)) & 1)
__global__ void __launch_bounds__(NWAVES * 64, 2) fwd(Args args) {
    extern __shared__ __attribute__((aligned(16))) unsigned char lds_raw[];
    LAS unsigned char* lds = (LAS unsigned char*)lds_raw;
    volatile LAS unsigned* MISC = (volatile LAS unsigned*)(lds + MISC_OFF);
    const int tid = threadIdx.x, G = gridDim.x;
    for (int u = tid; u < (LDS_BYTES - LDSCTL_OFF) / 4; u += NWAVES * 64) ((LAS unsigned*)(lds + LDSCTL_OFF))[u] = 0u;
    __syncthreads();
    XcdBarrier bar;
    { gu32* ctl = (gu32*)(args.ws + WS_CTL); bar.bar = (unsigned*)(ctl + CW_BAR); bar.x = 0; bar.st = nullptr;
      if (!MK_PER_PHASE) bar = xcd_barrier_post((unsigned*)(ctl + CW_BAR), MISC + 8); }
#define GRID_BAR() do { if (MK_PER_PHASE) { if (tid == 0) __hip_atomic_store((gu32*)bar.bar, 0xBADBA0u, RLX_AGENT); } else { xcd_barrier(bar); } } while (0)
    const int lo = args.ph_lo, hi = args.ph_hi;
#define IN(k) (lo <= (k) && (k) < hi)
#define BOTH(k) (IN(k) && IN((k) + 1))
#define SSQX(j) ((float*)(ws + WS_SSQX) + (size_t)(l * 3 + (j)) * T * 64)

    if (EN(0) && IN(0)) { REP(0) { p0_prologue(phase_args(), lds); __syncthreads(); } if (BOTH(0)) GRID_BAR(); }

    for (int l = 0; l < DEPTH; ++l) {
        const int pb = 1 + l * NPH;
        if (EN(1) && IN(pb + 0)) {
            const int nseg1 = (l == 0) ? 4 : 1, slot1 = (l == 0) ? (int)((blockIdx.x >> 3) & 3u) : -1;
            for (int seg = 0; seg < nseg1; ++seg) {
              if (seg == slot1) { conv_items(phase_args(), lds, I_IN, I_XKV0, I_XKV0 + I_XKV, I_LAYER - I_DN); __syncthreads(); }
              ArgsP A = phase_args(); unsigned char* ws = A->ws; unsigned char* wl = ws + WS_W + (size_t)l * WL_BYTES;
              pg8::Gemm g{(const bf16*)(ws + WS_XB), (const bf16*)(wl + WL_IN), T, IN_PAD, DM}; pg8::StaticOrder S; S.init(T, IN_PAD, G, (int)blockIdx.x); if (l == 0) { S.i0 = seg; S.i1 = seg + 1; }
              pg8::EpiInProj E{SSQX(0), (bf16*)(ws + WS_CQ), (bf16*)(ws + WS_CKV), (bf16*)(ws + WS_QSB), (bf16*)(ws + WS_KSB), (bf16*)(ws + WS_VSB), (float*)(ws + WS_KR), (float*)(ws + WS_SSQCQ) + (size_t)l * T * 16, (float*)(ws + WS_SSQCKV) + (size_t)l * T * 8, lds + RCACHE_OFF, 1 + 64 * (2 * l)};
              pg8::gemm_phase<pg8::EpiInProj, pg8::StaticOrder, true, true>(lds + RING_OFF, g, S, E); }
            { ArgsP A = phase_args(); unsigned char* ws = A->ws; unsigned char* wl = ws + WS_W + (size_t)l * WL_BYTES;
              pg8::Gemm g{(const bf16*)(ws + WS_MEMB), (const bf16*)(wl + WL_XKV), TMEM, 1024, DM}; pg8::StaticOrder S; S.init(TMEM, 1024, G, G == 256 ? (int)((blockIdx.x + 32u) & 255u) : (int)blockIdx.x);
              pg8::EpiScaleBf16<64> E{(const float*)(ws + WS_SSQMEM), 1.0f / 4096.0f, (bf16*)(ws + WS_KVX) + (size_t)l * TMEM * 1024, 1024};
              pg8::gemm_phase<pg8::EpiScaleBf16<64>, pg8::StaticOrder, true, true>(lds + RING_OFF, g, S, E); }
            if (BOTH(pb + 0)) GRID_BAR();
        }
        if (EN(2) && IN(pb + 1)) {
            { ArgsP A = phase_args(); unsigned char* ws = A->ws; unsigned char* wl = ws + WS_W + (size_t)l * WL_BYTES;
              pg8::Gemm g{(const bf16*)(ws + WS_CQ), (const bf16*)(wl + WL_QUP), T, QUP_N, QRANK}; pg8::StaticOrder S; S.init(T, QUP_N, G, (int)blockIdx.x);
              pg8::EpiScaleBf16<16> E{(const float*)(ws + WS_SSQCQ) + (size_t)l * T * 16, 1.0f / 1024.0f, (bf16*)(ws + WS_QRAW), QUP_N};
              pg8::gemm_phase<pg8::EpiScaleBf16<16>, pg8::StaticOrder, true, true>(lds + RING_OFF, g, S, E); }
            { ArgsP A = phase_args(); unsigned char* ws = A->ws; unsigned char* wl = ws + WS_W + (size_t)l * WL_BYTES;
              pg8::Gemm g{(const bf16*)(ws + WS_CKV), (const bf16*)(wl + WL_KVUP), T, KVUP_N, KVRANK}; pg8::StaticOrder S; S.init(T, KVUP_N, G, (int)blockIdx.x);
              pg8::EpiKvUp E{(const float*)(ws + WS_SSQCKV) + (size_t)l * T * 8, (bf16*)(ws + WS_KVRAW), A->in[10] + l * QKD, (LAS float*)(lds + XCH_OFF)};
              pg8::gemm_phase<pg8::EpiKvUp, pg8::StaticOrder, true, true>(lds + RING_OFF, g, S, E); }
            p_krn(phase_args(), l);
            if (BOTH(pb + 1)) GRID_BAR();
        }
        if (EN(4) && IN(pb + 3)) { REP(4) { p_attn_mfma(phase_args(), l, lds); } if (BOTH(pb + 3)) GRID_BAR(); }
        if (EN(6) && IN(pb + 5)) {
            ArgsP A = phase_args(); unsigned char* ws = A->ws; unsigned char* wl = ws + WS_W + (size_t)l * WL_BYTES; float* out = A->out;
            pg8::Gemm g{(const bf16*)(ws + WS_MIXED), (const bf16*)(wl + WL_OUT), T, DM, DM / 2, DM}; pg8::StaticOrder S; S.init(T, DM, G, (int)blockIdx.x); S.ksplit = 1;
            pg8::EpiResidual2 E{(bf16*)(ws + WS_XB), SSQX(1), (const float*)(ws + WS_SSQO)};
            pg8::gemm_phase<pg8::EpiResidual2, pg8::StaticOrder, true, true>(lds + RING_OFF, g, S, E);
            if (BOTH(pb + 5)) GRID_BAR();
        }
        if (EN(7) && IN(pb + 6)) {
            ArgsP A = phase_args(); unsigned char* ws = A->ws; unsigned char* wl = ws + WS_W + (size_t)l * WL_BYTES;
            pg8::Gemm g{(const bf16*)(ws + WS_XB), (const bf16*)(wl + WL_XQ), T, XW, DM / 4, DM}; pg8::SplitKOrder S; S.init(T, XW, 4, G, (int)blockIdx.x);
            pg8::EpiPartialF32 E{(float*)(ws + WS_QX), XW, (size_t)T * XW};
            pg8::gemm_phase<pg8::EpiPartialF32, pg8::SplitKOrder, true, true>(lds + RING_OFF, g, S, E);
            if (BOTH(pb + 6)) GRID_BAR();
        }
        if (EN(8) && IN(pb + 7)) { REP(8) p_xattn_mfma(phase_args(), l, lds); if (BOTH(pb + 7)) GRID_BAR(); }
        if (EN(9) && IN(pb + 8)) {
            ArgsP A = phase_args(); unsigned char* ws = A->ws; unsigned char* wl = ws + WS_W + (size_t)l * WL_BYTES; float* out = A->out;
            pg8::Gemm g{(const bf16*)(ws + WS_OX), (const bf16*)(wl + WL_XO), T, DM, XW}; pg8::StaticOrder S; S.init(T, DM, G, (int)blockIdx.x);
            pg8::EpiResidual E{nullptr, (bf16*)(ws + WS_XB), SSQX(2)};
            pg8::gemm_phase<pg8::EpiResidual, pg8::StaticOrder, true, true>(lds + RING_OFF, g, S, E);
            if (BOTH(pb + 8)) GRID_BAR();
        }
        if (EN(10) && IN(pb + 9)) {
            const int nseg10 = (l == 0) ? 8 : 1, slot10 = (l == 0) ? ((G == 256 && blockIdx.x >= 192) ? 8 : (int)((blockIdx.x >> 3) & 7u)) : -1;
            for (int seg = 0; seg <= nseg10; ++seg) {
              if (seg == slot10) { conv_items(phase_args(), lds, I_LAYER - I_DN, 2 * I_LAYER, 0, 0); __syncthreads(); }
              if (seg < nseg10) {
                ArgsP A = phase_args(); unsigned char* ws = A->ws; unsigned char* wl = ws + WS_W + (size_t)l * WL_BYTES;
                pg8::Gemm g{(const bf16*)(ws + WS_XB), (const bf16*)(wl + WL_GU), T, 2 * FF, DM}; pg8::StaticOrder S; S.init(T, 2 * FF, G, (int)blockIdx.x); if (l == 0) { S.i0 = seg; S.i1 = seg == 7 ? (1 << 28) : seg + 1; }
                pg8::EpiSwiGLU E{SSQX(2), (bf16*)(ws + WS_ACT), FF, lds + RCACHE_OFF, 1 + 64 * (2 * l + 1)};
                pg8::gemm_phase<pg8::EpiSwiGLU, pg8::StaticOrder, true, true>(lds + RING_OFF, g, S, E); } }
            if (BOTH(pb + 9)) GRID_BAR();
        }
        if (EN(11) && IN(pb + 10)) {
            ArgsP A = phase_args(); unsigned char* ws = A->ws; unsigned char* wl = ws + WS_W + (size_t)l * WL_BYTES; float* out = A->out;
            pg8::Gemm g{(const bf16*)(ws + WS_ACT), (const bf16*)(wl + WL_DN), T, DM, FF}; pg8::StaticOrder S; S.init(T, DM, G, (int)blockIdx.x);
            pg8::EpiResidual E{l == DEPTH - 1 ? out : nullptr, (bf16*)(ws + WS_XB), SSQX(3)};
            pg8::gemm_phase<pg8::EpiResidual, pg8::StaticOrder, true, true>(lds + RING_OFF, g, S, E);
            if (BOTH(pb + 10)) GRID_BAR();
        }
    }
#undef IN
#undef BOTH
}

extern "C" void kernel_launch(void* const* d_in, const int* in_sizes, int n_in, void* d_out, int out_size, void* d_ws, size_t ws_size, hipStream_t stream) {
    static int grid = 0;
    if (grid == 0) {
        if (n_in != 25 || in_sizes[0] != T * DM || out_size != T * DM || ws_size < WS_END) { fprintf(stderr, "kernel_launch: unexpected shapes (n_in %d, in0 %d, out %d, ws %zu < %zu); nothing launched\n", n_in, n_in > 0 ? in_sizes[0] : -1, out_size, ws_size, (size_t)WS_END); grid = -1; return; }
        int dev = 0, cus = 0, per_cu = 0;
        if (hipGetDevice(&dev) != hipSuccess || hipDeviceGetAttribute(&cus, hipDeviceAttributeMultiprocessorCount, dev) != hipSuccess) { grid = -1; return; }
        if (hipFuncSetAttribute((const void*)fwd, hipFuncAttributeMaxDynamicSharedMemorySize, LDS_BYTES) != hipSuccess) { fprintf(stderr, "kernel_launch: hipFuncSetAttribute failed\n"); grid = -1; return; }
        if (hipOccupancyMaxActiveBlocksPerMultiprocessor(&per_cu, (const void*)fwd, NWAVES * 64, LDS_BYTES) != hipSuccess || per_cu < 1) { fprintf(stderr, "kernel_launch: occupancy query reports %d\n", per_cu); }
        (void)hipGetLastError();
        grid = cus;
    }
    if (grid < 0) return;
    if (hipMemsetAsync((char*)d_ws + WS_CTL, 0, CTL_ZERO_BYTES, stream) != hipSuccess) { fprintf(stderr, "kernel_launch: memset failed\n"); return; }
    Args a{};
    for (int i = 0; i < 25; ++i) a.in[i] = (const float*)d_in[i];
    a.out = (float*)d_out; a.ws = (unsigned char*)d_ws; a.pad = 0;
#if MK_PER_PHASE
    for (int p = 0; p < N_PHASES; ++p) { a.ph_lo = p; a.ph_hi = p + 1; a.li = p; hipLaunchKernelGGL(fwd, dim3(grid), dim3(NWAVES * 64), LDS_BYTES, stream, a); }
#else
    a.ph_lo = 0; a.ph_hi = N_PHASES; a.li = 0;
    hipLaunchKernelGGL(fwd, dim3(grid), dim3(NWAVES * 64), LDS_BYTES, stream, a);
#endif
    const hipError_t le = hipPeekAtLastError();
    if (le != hipSuccess) fprintf(stderr, "kernel_launch: launch failed: %s\n", hipGetErrorName(le));
}
```

```cpp
#include <hip/hip_runtime.h>
#include <cstdio>
#include <cstdint>
namespace pg8 {
#define PG8_LAS __attribute__((address_space(3)))
typedef unsigned short bf16_t;
typedef short bf16x8 __attribute__((ext_vector_type(8)));
typedef float f32x4 __attribute__((ext_vector_type(4)));
typedef unsigned u32x4 __attribute__((ext_vector_type(4)));
constexpr int BM = 256, BK = 64, HALF = 128, HTB = HALF * BK * 2  , STAGE_BYTES = 8 * HTB, NXCD = 8, WGM = 8;

__host__ __device__ __forceinline__ int lds_byte(int r, int c) { const int st = (r >> 4) * 2 + (c >> 5), rr = r & 15, cc = c & 31, ob = rr * 64 + cc * 2; return st * 1024 + (ob ^ (((ob >> 9) & 1) << 5)); }
__host__ __device__ __forceinline__ void stage_rc(int b, int& R, int& C) { const int st = b / 1024, sb = b % 1024, swz = sb ^ (((sb >> 9) & 1) << 5); R = (st >> 1) * 16 + swz / 64; C = (st & 1) * 32 + (swz % 64) / 2; }
__host__ __device__ __forceinline__ int perm32(int rho) { const int n = rho >> 4, i = rho & 15; return 8 * (i >> 2) + 4 * n + (i & 3); }

struct Unit { int pm, pn; int ks = 0; };
struct Gemm { const bf16_t* A; const bf16_t* Bt; int M, N, K; int ld = 0; };

struct StaticOrder {
    int nM, nN, nwg, G, c;
    int i0 = 0, i1 = 1 << 28;
    int ksplit = 0;
    __host__ __device__ void init(int M, int N, int G_, int c_) { nM = M / BM; nN = N / BM; nwg = nM * nN; G = G_; c = c_; }
    __host__ __device__ bool next(int i, Unit& u) const {
        const int rnd = (ksplit ? (i >> 1) : i) + i0; if (rnd >= i1) return false;
        const long L = (long)rnd * G + c; if (L >= nwg) return false; u.ks = ksplit ? (i & 1) : 0;
        int wgid = (int)L; { const int q = nwg / NXCD, r = nwg % NXCD, xcd = wgid % NXCD, off = wgid / NXCD; wgid = (xcd < r ? xcd * (q + 1) : r * (q + 1) + (xcd - r) * q) + off; }
        const int nig = WGM * nN, gid = wgid / nig, fm = gid * WGM, gsz = (nM - fm) < WGM ? (nM - fm) : WGM;
        u.pm = fm + ((wgid % nig) % gsz); u.pn = (wgid % nig) / gsz; return true;
    }
    __device__ __forceinline__ void a_ready(const Unit&) const {}
    __device__ __forceinline__ void done(const Unit&) const {}
};

__device__ __forceinline__ unsigned cvt_pk_bf16(float lo, float hi) { unsigned r; asm volatile("v_cvt_pk_bf16_f32 %0, %1, %2" : "=v"(r) : "v"(lo), "v"(hi)); return r; }
constexpr float RMS_EPS = 1e-6f;
__device__ __forceinline__ float ld_sc1(const float* p) { return __hip_atomic_load(p, __ATOMIC_RELAXED, __HIP_MEMORY_SCOPE_AGENT); }
__device__ __forceinline__ void add_f32(float* p, float v) { (void)__hip_atomic_fetch_add(p, v, __ATOMIC_RELAXED, __HIP_MEMORY_SCOPE_AGENT); }
__device__ __forceinline__ float sq4(const f32x4 v) { return (v[0] * v[0] + v[1] * v[1]) + (v[2] * v[2] + v[3] * v[3]); }
__device__ __forceinline__ u32x4 pack8(const f32x4 a, const f32x4 b) { u32x4 w; w.x = cvt_pk_bf16(a[0], a[1]); w.y = cvt_pk_bf16(a[2], a[3]); w.z = cvt_pk_bf16(b[0], b[1]); w.w = cvt_pk_bf16(b[2], b[3]); return w; }

template <int NS>
__device__ __forceinline__ float row_ssq(const float* part, int row, int fq) {
    float s = 0.f;
    if constexpr (NS >= 16) { constexpr int PER = NS / 4; const f32x4* p = (const f32x4*)(part + (size_t)row * NS + fq * PER);
#pragma unroll
        for (int i = 0; i < PER / 4; ++i) { const f32x4 v = p[i]; s += (v[0] + v[1]) + (v[2] + v[3]); } }
    else { static_assert(NS == 8, "NS"); if (fq < 2) { const f32x4 v = *(const f32x4*)(part + (size_t)row * 8 + fq * 4); s = (v[0] + v[1]) + (v[2] + v[3]); } }
    s += __shfl_xor(s, 16); s += __shfl_xor(s, 32); return s;
}
template <int NS>
__device__ __forceinline__ void row_rinv8(float (&rinv)[8], const float* ssq, float inv_n, int row0, int fr, int fq, PG8_LAS float* cache, int tag) {
    if (((const PG8_LAS int*)cache)[128] == tag) {
#pragma unroll
        for (int i = 0; i < 8; ++i) rinv[i] = cache[(i >> 2) * 64 + (i & 3) * 16 + fr];
    } else {
#pragma unroll
        for (int i = 0; i < 8; ++i) { const float r = rsqrtf(row_ssq<NS>(ssq, row0 + (i >> 2) * HALF + (i & 3) * 16, fq) * inv_n + RMS_EPS); rinv[i] = r; if (fq == 0) cache[(i >> 2) * 64 + (i & 3) * 16 + fr] = r; }
        if (fr == 0 && fq == 0) ((PG8_LAS int*)cache)[128] = tag;
    }
}
template <int NS> struct EpiScaleBf16 {
    static constexpr bool PERM = true, AFTER_DRAIN = false;
    const float* ssq; float inv_n; bf16_t* O; int ldc;
    __device__ __forceinline__ void operator()(const f32x4 (&acc)[2][2][4][2], const Unit& u, int wr, int wc, int fr, int fq) const {
        const int row0 = u.pm * BM + wr * 64 + fr, col0 = u.pn * BM + wc * 32 + 8 * fq;
#pragma unroll
        for (int ai = 0; ai < 2; ++ai)
#pragma unroll
            for (int m = 0; m < 4; ++m) { const int row = row0 + ai * HALF + m * 16; const float rinv = rsqrtf(row_ssq<NS>(ssq, row, fq) * inv_n + RMS_EPS);
                bf16_t* rowp = O + (size_t)row * ldc + col0;
#pragma unroll
                for (int bj = 0; bj < 2; ++bj) *(u32x4*)(rowp + bj * HALF) = pack8(acc[ai][bj][m][0] * rinv, acc[ai][bj][m][1] * rinv); }
    }
};

struct EpiInProj {
    static constexpr bool PERM = true, AFTER_DRAIN = false;
    const float* ssq_x; bf16_t *cq, *ckv, *qsb, *ksb, *vsb; float* kr; float *ssq_cq, *ssq_ckv; PG8_LAS unsigned char* rcache; int tagbase;
    __device__ __forceinline__ void operator()(const f32x4 (&acc)[2][2][4][2], const Unit& u, int wr, int wc, int fr, int fq) const {
        const int pn = u.pn, row0 = u.pm * BM + wr * 64 + fr, cw = wc * 32 + 8 * fq;
        bf16_t* base; int ldc, colt; float* ssq = nullptr; int ns = 0, slot = 0;
        if (pn < 4) { base = cq; ldc = 1024; colt = pn * 256; ssq = ssq_cq; ns = 16; slot = pn * 4 + wc; }
        else if (pn < 6) { base = ckv; ldc = 512; colt = (pn - 4) * 256; ssq = ssq_ckv; ns = 8; slot = (pn - 4) * 4 + wc; }
        else if (pn < 14) { base = qsb; ldc = 2048; colt = (pn - 6) * 256; }
        else if (pn < 22) { base = ksb; ldc = 2048; colt = (pn - 14) * 256; }
        else if (pn < 30) { base = vsb; ldc = 2048; colt = (pn - 22) * 256; }
        else { base = nullptr; ldc = 0; colt = 0; }
        float rinv8[8]; row_rinv8<64>(rinv8, ssq_x, 1.0f / 4096.0f, row0, fr, fq, (PG8_LAS float*)(rcache + (wr * 4 + wc) * 528), tagbase + pn * 0 + u.pm);
#pragma unroll
        for (int ai = 0; ai < 2; ++ai)
#pragma unroll
            for (int m = 0; m < 4; ++m) { const int row = row0 + ai * HALF + m * 16; const float rinv = rinv8[ai * 4 + m];
                if (base) { float s = 0.f; bf16_t* rowp = base + (size_t)row * ldc + colt + cw;
#pragma unroll
                    for (int bj = 0; bj < 2; ++bj) { const f32x4 v0 = acc[ai][bj][m][0] * rinv, v1 = acc[ai][bj][m][1] * rinv; *(u32x4*)(rowp + bj * HALF) = pack8(v0, v1); s += sq4(v0) + sq4(v1); }
                    if (ssq) { s += __shfl_xor(s, 16); s += __shfl_xor(s, 32); if (fq == 0) ssq[(size_t)row * ns + slot] = s; }
                } else if (wc < 2) {
                    const f32x4 v0 = acc[ai][0][m][0] * rinv, v1 = acc[ai][0][m][1] * rinv; float* kp = kr + (size_t)row * 64 + cw; *(f32x4*)kp = v0; *(f32x4*)(kp + 4) = v1; }
            }
    }
};

struct EpiKvUp {
    static constexpr bool PERM = true, AFTER_DRAIN = false;
    const float* ssq; bf16_t* O; const float* gk; PG8_LAS float* xch;
    __device__ __forceinline__ void operator()(const f32x4 (&acc)[2][2][4][2], const Unit& u, int wr, int wc, int fr, int fq) const {
        const int row0 = u.pm * BM + wr * 64 + fr, col0 = u.pn * BM + wc * 32 + 8 * fq;
        float rinv[8];
#pragma unroll
        for (int i = 0; i < 8; ++i) rinv[i] = rsqrtf(row_ssq<8>(ssq, row0 + (i >> 2) * HALF + (i & 3) * 16, fq) * (1.0f / 512.0f) + RMS_EPS);
#pragma unroll
        for (int i = 0; i < 8; ++i) { const int ai = i >> 2, m = i & 3; const f32x4 k0 = acc[ai][0][m][0] * rinv[i], k1 = acc[ai][0][m][1] * rinv[i]; float s = sq4(k0) + sq4(k1);
            s += __shfl_xor(s, 16); s += __shfl_xor(s, 32); if (fq == 0) xch[(ai * HALF + wr * 64 + m * 16 + fr) * 4 + wc] = s;
            *(u32x4*)(O + (size_t)(row0 + ai * HALF + m * 16) * 4096 + col0 + HALF) = pack8(acc[ai][1][m][0] * rinv[i], acc[ai][1][m][1] * rinv[i]); }
        asm volatile("s_waitcnt lgkmcnt(0)\n\ts_barrier" ::: "memory");
        const f32x4 g0 = *(const f32x4*)(gk + wc * 32 + 8 * fq), g1 = *(const f32x4*)(gk + wc * 32 + 8 * fq + 4);
#pragma unroll
        for (int i = 0; i < 8; ++i) { const int ai = i >> 2, m = i & 3; const f32x4 p = *(const PG8_LAS f32x4*)(xch + (ai * HALF + wr * 64 + m * 16 + fr) * 4);
            const float rk = rsqrtf(((p[0] + p[1]) + (p[2] + p[3])) * (1.0f / 128.0f) + RMS_EPS) * rinv[i];
            *(u32x4*)(O + (size_t)(row0 + ai * HALF + m * 16) * 4096 + col0) = pack8(acc[ai][0][m][0] * rk * g0, acc[ai][0][m][1] * rk * g1); }
        asm volatile("s_waitcnt lgkmcnt(0)\n\ts_barrier" ::: "memory");
    }
};

__device__ __forceinline__ void unpack8(const u32x4 w, f32x4& a, f32x4& b) {
    a[0] = __uint_as_float(w.x << 16); a[1] = __uint_as_float(w.x & 0xffff0000u); a[2] = __uint_as_float(w.y << 16); a[3] = __uint_as_float(w.y & 0xffff0000u);
    b[0] = __uint_as_float(w.z << 16); b[1] = __uint_as_float(w.z & 0xffff0000u); b[2] = __uint_as_float(w.w << 16); b[3] = __uint_as_float(w.w & 0xffff0000u);
}
struct EpiResidual {
    static constexpr bool PERM = true, AFTER_DRAIN = false;
    float* out; bf16_t* xb; float* ssq;
    __device__ __forceinline__ void operator()(const f32x4 (&acc)[2][2][4][2], const Unit& u, int wr, int wc, int fr, int fq) const {
        const int row0 = u.pm * BM + wr * 64 + fr, col0 = u.pn * BM + wc * 32 + 8 * fq;
#pragma unroll
        for (int ai = 0; ai < 2; ++ai)
#pragma unroll
            for (int m = 0; m < 4; ++m) { const int row = row0 + ai * HALF + m * 16; const size_t off = (size_t)row * 4096 + col0; float s = 0.f;
#pragma unroll
                for (int bj = 0; bj < 2; ++bj) { bf16_t* xp = xb + off + bj * HALF; f32x4 b0, b1; unpack8(*(const u32x4*)xp, b0, b1); const f32x4 v0 = acc[ai][bj][m][0] + b0, v1 = acc[ai][bj][m][1] + b1;
                    if (out) { float* op = out + off + bj * HALF; *(f32x4*)op = v0; *(f32x4*)(op + 4) = v1; } else { *(u32x4*)xp = pack8(v0, v1); s += sq4(v0) + sq4(v1); } }
                if (!out) { s += __shfl_xor(s, 16); s += __shfl_xor(s, 32); if (fq == 0) ssq[(size_t)row * 64 + u.pn * 4 + wc] = s; } }
    }
};

struct EpiResidual2 {
    static constexpr bool PERM = true, AFTER_DRAIN = false;
    bf16_t* xb; float* ssq; const float* osq;
    __device__ __forceinline__ void operator()(const f32x4 (&acc)[2][2][4][2], const Unit& u, int wr, int wc, int fr, int fq) const {
        const int row0 = u.pm * BM + wr * 64 + fr, col0 = u.pn * BM + wc * 32 + 8 * fq; const bool second = u.ks != 0;
#pragma unroll
        for (int ai = 0; ai < 2; ++ai)
#pragma unroll
            for (int m = 0; m < 4; ++m) { const int row = row0 + ai * HALF + m * 16; const size_t off = (size_t)row * 4096 + col0; float s = 0.f;
                float q; { const f32x4 v = *(const f32x4*)(osq + (size_t)row * 32 + (second ? 16 : 0) + 4 * fq); q = (v[0] + v[1]) + (v[2] + v[3]); q += __shfl_xor(q, 16); q += __shfl_xor(q, 32); }
                const float rn = rsqrtf(q * (1.0f / 2048.0f) + RMS_EPS);
#pragma unroll
                for (int bj = 0; bj < 2; ++bj) { bf16_t* xp = xb + off + bj * HALF; f32x4 b0, b1; unpack8(__builtin_nontemporal_load((const u32x4*)xp), b0, b1);
                    const f32x4 v0 = acc[ai][bj][m][0] * rn + b0, v1 = acc[ai][bj][m][1] * rn + b1;
                    *(u32x4*)xp = pack8(v0, v1); if (second) s += sq4(v0) + sq4(v1); }
                if (second) { s += __shfl_xor(s, 16); s += __shfl_xor(s, 32); if (fq == 0) ssq[(size_t)row * 64 + u.pn * 4 + wc] = s; } }
    }
};

struct EpiSwiGLU {
    static constexpr bool PERM = true, AFTER_DRAIN = false;
    const float* ssq; bf16_t* act; int ldc; PG8_LAS unsigned char* rcache; int tagbase;
    __device__ __forceinline__ static float silu(float x) { return x * __builtin_amdgcn_rcpf(1.0f + __expf(-x)); }
    __device__ __forceinline__ void operator()(const f32x4 (&acc)[2][2][4][2], const Unit& u, int wr, int wc, int fr, int fq) const {
        const int row0 = u.pm * BM + wr * 64 + fr, col0 = u.pn * HALF + wc * 32 + 8 * fq;
        float rinv8[8]; row_rinv8<64>(rinv8, ssq, 1.0f / 4096.0f, row0, fr, fq, (PG8_LAS float*)(rcache + (wr * 4 + wc) * 528), tagbase + u.pm);
#pragma unroll
        for (int ai = 0; ai < 2; ++ai)
#pragma unroll
            for (int m = 0; m < 4; ++m) { const int row = row0 + ai * HALF + m * 16; const float rinv = rinv8[ai * 4 + m];
                const float c1 = -rinv * 1.4426950408889634f, c2 = rinv * rinv; float gg[8], ee[8];
#pragma unroll
                for (int e = 0; e < 8; ++e) { gg[e] = acc[ai][0][m][e >> 2][e & 3]; ee[e] = __builtin_amdgcn_exp2f(gg[e] * c1); }
#pragma unroll
                for (int e = 0; e < 8; ++e) ee[e] = __builtin_amdgcn_rcpf(1.0f + ee[e]);
                f32x4 h0, h1;
#pragma unroll
                for (int e = 0; e < 4; ++e) { h0[e] = ((gg[e] * acc[ai][1][m][0][e]) * c2) * ee[e]; h1[e] = ((gg[4 + e] * acc[ai][1][m][1][e]) * c2) * ee[4 + e]; }
                *(u32x4*)(act + (size_t)row * ldc + col0) = pack8(h0, h1); }
    }
};


struct EpiPartialF32 {
    static constexpr bool PERM = true, AFTER_DRAIN = false;
    float* part; int ldc; size_t slice_stride;
    __device__ __forceinline__ void operator()(const f32x4 (&acc)[2][2][4][2], const Unit& u, int wr, int wc, int fr, int fq) const {
        const int row0 = u.pm * BM + wr * 64 + fr, col0 = u.pn * BM + wc * 32 + 8 * fq; float* base = part + (size_t)u.ks * slice_stride;
#pragma unroll
        for (int ai = 0; ai < 2; ++ai)
#pragma unroll
            for (int m = 0; m < 4; ++m) { float* rowp = base + (size_t)(row0 + ai * HALF + m * 16) * ldc + col0;
#pragma unroll
                for (int bj = 0; bj < 2; ++bj) { *(f32x4*)(rowp + bj * HALF) = acc[ai][bj][m][0]; *(f32x4*)(rowp + bj * HALF + 4) = acc[ai][bj][m][1]; } }
    }
};
struct EpiPartialBf16 {
    static constexpr bool PERM = true, AFTER_DRAIN = false;
    bf16_t* part; int ldc; size_t slice_stride;
    __device__ __forceinline__ void operator()(const f32x4 (&acc)[2][2][4][2], const Unit& u, int wr, int wc, int fr, int fq) const {
        const int row0 = u.pm * BM + wr * 64 + fr, col0 = u.pn * BM + wc * 32 + 8 * fq; bf16_t* base = part + (size_t)u.ks * slice_stride;
#pragma unroll
        for (int ai = 0; ai < 2; ++ai)
#pragma unroll
            for (int m = 0; m < 4; ++m) { bf16_t* rowp = base + (size_t)(row0 + ai * HALF + m * 16) * ldc + col0;
#pragma unroll
                for (int bj = 0; bj < 2; ++bj) *(u32x4*)(rowp + bj * HALF) = pack8(acc[ai][bj][m][0], acc[ai][bj][m][1]); }
    }
};
struct SplitKOrder {
    int nN, KS, nwg, G, c;
    __device__ void init(int M, int N, int KS_, int G_, int c_) { nN = N / BM; KS = KS_; nwg = (M / BM) * nN * KS; G = G_; c = c_; }
    __device__ bool next(int i, Unit& u) const { const long L = (long)i * G + c; if (L >= nwg) return false; const int per = nN * KS, id = (int)L; u.pm = id / per; const int r = id % per; u.pn = r / KS; u.ks = r % KS; return true; }
    __device__ __forceinline__ void a_ready(const Unit&) const {}
    __device__ __forceinline__ void done(const Unit&) const {}
};
template <class Epi, class Sched, bool ALIGN_EPI = false, bool SP2 = false>
__device__ __forceinline__ void gemm_phase(PG8_LAS unsigned char* lds, const Gemm g, const Sched& S, const Epi& E) {
    int tid_ = threadIdx.x; asm volatile("" : "+v"(tid_));
    const int tid = tid_, wid = __builtin_amdgcn_readfirstlane(tid >> 6), lane = tid & 63, wr = wid >> 2, wc = wid & 3, fr = lane & 15, fq = lane >> 4;
    const int K = g.K, nt = K / BK, LD = g.ld ? g.ld : K;
    unsigned voffA[2], voffB[2];
#pragma unroll
    for (int i = 0; i < 2; ++i) { int R, C; stage_rc(tid * 16 + i * 8192, R, C); const int Rb = Epi::PERM ? ((R & ~31) + perm32(R & 31)) : R;
        voffA[i] = (unsigned)(R * LD + C) * 2u; voffB[i] = (unsigned)(Rb * LD + C) * 2u; }
    const size_t kstep = (size_t)(BK * 2);
    const size_t hstep = (size_t)HALF * LD * 2;
    const size_t tstep = 2 * hstep;
    const unsigned ldsw = (unsigned)wid * 1024u;
    const int aoff = lds_byte(wr * 64 + fr, fq * 8), boff = lds_byte(wc * 32 + fr, fq * 8);
#define PG8_SA(b, h) (((b) * 2 + (h)) * HTB)
#define PG8_SB(b, h) ((4 + (b) * 2 + (h)) * HTB)
#define PG8_STAGE(bufoff, gbase, voff) do { _Pragma("unroll") for (int _i = 0; _i < 2; ++_i) \
        __builtin_amdgcn_global_load_lds((const unsigned*)((const char*)(gbase) + (voff)[_i]), (PG8_LAS unsigned*)(lds + (bufoff) + ldsw + _i * 8192), 16, 0, 0); } while (0)
#define PG8_LDA(dst, b, h) do { _Pragma("unroll") for (int m = 0; m < 4; ++m) _Pragma("unroll") for (int k = 0; k < 2; ++k) dst[m][k] = *(const PG8_LAS bf16x8*)(lds + PG8_SA(b, h) + aoff + m * 2048 + k * 1024); } while (0)
#define PG8_LDB(dst, b, h) do { _Pragma("unroll") for (int n = 0; n < 2; ++n) _Pragma("unroll") for (int k = 0; k < 2; ++k) dst[n][k] = *(const PG8_LAS bf16x8*)(lds + PG8_SB(b, h) + boff + n * 2048 + k * 1024); } while (0)
#define PG8_MMA(ai, bj, At, Bt) do { __builtin_amdgcn_s_setprio(1); _Pragma("unroll") for (int m = 0; m < 4; ++m) _Pragma("unroll") for (int n = 0; n < 2; ++n) _Pragma("unroll") for (int k = 0; k < 2; ++k) \
        acc[ai][bj][m][n] = __builtin_amdgcn_mfma_f32_16x16x32_bf16(Bt[n][k], At[m][k], acc[ai][bj][m][n], 0, 0, 0); __builtin_amdgcn_s_setprio(0); } while (0)
#define PG8_WAIT_V(n) asm volatile("s_waitcnt vmcnt(" #n ")" ::: "memory")
#define PG8_WAIT_L(n) asm volatile("s_waitcnt lgkmcnt(" #n ")" ::: "memory")
#define PG8_BAR __builtin_amdgcn_s_barrier()
#define PG8_SCHED __builtin_amdgcn_sched_barrier(0)
    Unit cur, nxt; int ui = 0;
    if (!S.next(0, cur)) return;
    f32x4 acc[2][2][4][2];
#pragma unroll
    for (int a = 0; a < 2; ++a)
#pragma unroll
        for (int b = 0; b < 2; ++b)
#pragma unroll
            for (int m = 0; m < 4; ++m)
#pragma unroll
                for (int n = 0; n < 2; ++n) acc[a][b][m][n] = (f32x4){0.f, 0.f, 0.f, 0.f};
    bf16x8 At[4][2], B0[2][2], B1[2][2];
    const char* cA = (const char*)g.A + (size_t)cur.pm * tstep + (size_t)cur.ks * K * 2; const char* cB = (const char*)g.Bt + (size_t)cur.pn * tstep + (size_t)cur.ks * K * 2;
    S.a_ready(cur);
    if constexpr (SP2) {
        PG8_STAGE(PG8_SB(0, 0), cB, voffB); PG8_STAGE(PG8_SB(0, 1), cB + hstep, voffB); PG8_STAGE(PG8_SA(0, 0), cA, voffA); PG8_STAGE(PG8_SA(0, 1), cA + hstep, voffA);
        if (wr == 1) PG8_BAR;
        PG8_WAIT_V(2); PG8_BAR;
        PG8_STAGE(PG8_SB(1, 0), cB + kstep, voffB); PG8_STAGE(PG8_SA(1, 0), cA + kstep, voffA); PG8_STAGE(PG8_SB(1, 1), cB + hstep + kstep, voffB);
        PG8_WAIT_V(6); PG8_BAR;
    } else {
        PG8_STAGE(PG8_SB(0, 0), cB, voffB); PG8_STAGE(PG8_SA(0, 0), cA, voffA); PG8_STAGE(PG8_SB(0, 1), cB + hstep, voffB); PG8_STAGE(PG8_SA(0, 1), cA + hstep, voffA);
        if (wr == 1) PG8_BAR;
        PG8_WAIT_V(4); PG8_BAR;
        PG8_STAGE(PG8_SB(1, 0), cB + kstep, voffB); PG8_STAGE(PG8_SA(1, 0), cA + kstep, voffA); PG8_STAGE(PG8_SB(1, 1), cB + hstep + kstep, voffB);
        PG8_WAIT_V(6); PG8_BAR;
    }
    for (;;) {
        const bool has_next = S.next(ui + 1, nxt);
        const char* nA = has_next ? (const char*)g.A + (size_t)nxt.pm * tstep + (size_t)nxt.ks * K * 2 : cA; const char* nB = has_next ? (const char*)g.Bt + (size_t)nxt.pn * tstep + (size_t)nxt.ks * K * 2 : cB;
        for (int t = 0; t < nt; t += 2) {
            const bool last = (t == nt - 2);
            const char* a1 = cA + (size_t)(t + 1) * kstep;
            const char* a2 = last ? nA : cA + (size_t)(t + 2) * kstep; const char* b2 = last ? nB : cB + (size_t)(t + 2) * kstep;
            const char* a3 = a2 + kstep; const char* b3 = b2 + kstep;
            if (last && has_next) S.a_ready(nxt);
            if constexpr (SP2) {
            PG8_LDB(B0, 0, 0); PG8_LDB(B1, 0, 1); PG8_SCHED; PG8_LDA(At, 0, 0); PG8_STAGE(PG8_SA(1, 1), a1 + hstep, voffA);
            PG8_WAIT_V(8); PG8_WAIT_L(0); PG8_BAR; PG8_MMA(0, 0, At, B0); PG8_MMA(0, 1, At, B1); PG8_BAR; PG8_SCHED;
            PG8_LDA(At, 0, 1); PG8_STAGE(PG8_SB(0, 0), b2, voffB); PG8_STAGE(PG8_SB(0, 1), b2 + hstep, voffB); PG8_STAGE(PG8_SA(0, 0), a2, voffA);
            PG8_WAIT_V(8); PG8_WAIT_L(0); PG8_BAR; PG8_MMA(1, 0, At, B0); PG8_MMA(1, 1, At, B1); PG8_BAR; PG8_SCHED;
            PG8_LDB(B0, 1, 0); PG8_LDB(B1, 1, 1); PG8_SCHED; PG8_LDA(At, 1, 0); PG8_STAGE(PG8_SA(0, 1), a2 + hstep, voffA);
            PG8_WAIT_V(8); PG8_WAIT_L(0); PG8_BAR; PG8_MMA(0, 0, At, B0); PG8_MMA(0, 1, At, B1); PG8_BAR; PG8_SCHED;
            PG8_LDA(At, 1, 1); PG8_STAGE(PG8_SB(1, 0), b3, voffB); PG8_STAGE(PG8_SB(1, 1), b3 + hstep, voffB); PG8_STAGE(PG8_SA(1, 0), a3, voffA);
            PG8_WAIT_V(8); PG8_WAIT_L(0); PG8_BAR; PG8_MMA(1, 0, At, B0); PG8_MMA(1, 1, At, B1); PG8_BAR; PG8_SCHED;
            } else {
            PG8_LDB(B0, 0, 0); PG8_SCHED; PG8_LDA(At, 0, 0); PG8_STAGE(PG8_SA(1, 1), a1 + hstep, voffA);
            PG8_WAIT_L(8); PG8_BAR; PG8_WAIT_L(0); PG8_MMA(0, 0, At, B0); PG8_BAR; PG8_SCHED;
            PG8_LDB(B1, 0, 1); PG8_STAGE(PG8_SB(0, 0), b2, voffB);
            PG8_BAR; PG8_WAIT_L(0); PG8_MMA(0, 1, At, B1); PG8_BAR;
            PG8_LDA(At, 0, 1); PG8_STAGE(PG8_SA(0, 0), a2, voffA);
            PG8_BAR; PG8_WAIT_L(0); PG8_MMA(1, 0, At, B0); PG8_BAR; PG8_SCHED;
            PG8_STAGE(PG8_SB(0, 1), b2 + hstep, voffB);
            PG8_WAIT_V(6); PG8_BAR; PG8_MMA(1, 1, At, B1); PG8_BAR;
            PG8_LDB(B0, 1, 0); PG8_SCHED; PG8_LDA(At, 1, 0); PG8_STAGE(PG8_SA(0, 1), a2 + hstep, voffA);
            PG8_WAIT_L(8); PG8_BAR; PG8_WAIT_L(0); PG8_MMA(0, 0, At, B0); PG8_BAR; PG8_SCHED;
            PG8_LDB(B1, 1, 1); PG8_STAGE(PG8_SB(1, 0), b3, voffB);
            PG8_BAR; PG8_WAIT_L(0); PG8_MMA(0, 1, At, B1); PG8_BAR;
            PG8_LDA(At, 1, 1); PG8_STAGE(PG8_SA(1, 0), a3, voffA);
            PG8_BAR; PG8_WAIT_L(0); PG8_MMA(1, 0, At, B0); PG8_BAR; PG8_SCHED;
            PG8_STAGE(PG8_SB(1, 1), b3 + hstep, voffB);
            PG8_WAIT_V(6); PG8_BAR; PG8_MMA(1, 1, At, B1); PG8_BAR;
            }
        }
        if constexpr (ALIGN_EPI) { if (wr == 0) PG8_BAR; }
        if constexpr (!Epi::AFTER_DRAIN) { E(acc, cur, wr, wc, fr, fq); S.done(cur); }
        if (!has_next) break;
#pragma unroll
        for (int a = 0; a < 2; ++a)
#pragma unroll
            for (int b = 0; b < 2; ++b)
#pragma unroll
                for (int m = 0; m < 4; ++m)
#pragma unroll
                    for (int n = 0; n < 2; ++n) acc[a][b][m][n] = (f32x4){0.f, 0.f, 0.f, 0.f};
        cur = nxt; cA = nA; cB = nB; ++ui;
        if constexpr (ALIGN_EPI) { if (wr == 1) PG8_BAR; }
    }
    PG8_WAIT_V(0);
    if constexpr (!ALIGN_EPI) { if (wr == 0) PG8_BAR; }
    PG8_BAR;
    if constexpr (Epi::AFTER_DRAIN) { E.fused(acc, cur, wr, wc, fr, fq, lds, wid, lane); S.done(cur); }
#undef PG8_SA
#undef PG8_SB
#undef PG8_STAGE
#undef PG8_LDA
#undef PG8_LDB
#undef PG8_MMA
#undef PG8_WAIT_V
#undef PG8_WAIT_L
#undef PG8_BAR
#undef PG8_SCHED
}
}
constexpr int NWAVES = 8;
constexpr int T = 8192, DM = 4096, SEQ = 2048, NBATCH = 4, MEMLEN = 256, TMEM = NBATCH * MEMLEN;
constexpr int QRANK = 1024, KVRANK = 512, NH = 16, QKD = 192, QUP_N = NH * QKD, KVUP_N = NH * 256;
constexpr int SBW = 2048, XW = 512, FF = 11008, IN_COLS = 7744, IN_PAD = 7936, DEPTH = 2;
constexpr int NPH = 11;
constexpr int N_PHASES = 1 + DEPTH * NPH;
#ifndef MK_PER_PHASE
#define MK_PER_PHASE 0
#define DBL_MASK 0
#endif

constexpr size_t MiB = 1u << 20;
constexpr size_t WS_CTL = 0, CTL_ZERO_BYTES = 1 * MiB;
constexpr size_t WL_IN = 0, WL_QUP = 62 * MiB, WL_KVUP = 68 * MiB, WL_OUT = 72 * MiB, WL_XQ = 104 * MiB, WL_XKV = 108 * MiB, WL_XO = 116 * MiB, WL_GU = 120 * MiB, WL_DN = 292 * MiB, WL_BYTES = 378 * MiB;
constexpr size_t WS_W = 2 * MiB;
constexpr size_t WS_XB = WS_W + DEPTH * WL_BYTES;
constexpr size_t WS_MEMB = WS_XB + 64 * MiB;
constexpr size_t WS_KVX = WS_MEMB + 8 * MiB;
constexpr size_t WS_QX = WS_KVX + 4 * MiB;
constexpr size_t WS_OX = WS_QX + 64 * MiB;
constexpr size_t WS_R1 = WS_OX + 8 * MiB;
constexpr size_t WS_CQ = WS_R1, WS_CKV = WS_CQ + 16 * MiB, WS_QSB = WS_CKV + 8 * MiB, WS_KSB = WS_QSB + 32 * MiB, WS_VSB = WS_KSB + 32 * MiB, WS_KR = WS_VSB + 32 * MiB;
constexpr size_t WS_QRAW = WS_KR + 2 * MiB, WS_KVRAW = WS_QRAW + 48 * MiB, WS_MIXED = WS_KVRAW + 64 * MiB;
constexpr size_t WS_R1_END = WS_MIXED + 64 * MiB;
constexpr size_t WS_ACT = WS_R1;
static_assert(WS_ACT + 172 * MiB <= WS_R1_END, "ACT fits in R1");
constexpr size_t WS_SSQX = WS_R1_END;
constexpr size_t WS_SSQCQ = WS_SSQX + 14 * MiB;
constexpr size_t WS_SSQCKV = WS_SSQCQ + 1 * MiB;
constexpr size_t WS_SSQMEM = WS_SSQCKV + 1 * MiB;
constexpr size_t WS_KRN = WS_SSQMEM + 1 * MiB;
constexpr size_t WS_SSQO = WS_KRN + 1 * MiB;
constexpr size_t WS_END = WS_SSQO + 1 * MiB;
constexpr int CW_TMO = 0, CW_CODE = 1, CW_BAR = 4096;
static_assert((CW_BAR + 3456) * 4 <= (int)CTL_ZERO_BYTES, "CTL words inside the memset region");

constexpr int RING_OFF = 0, RING_BYTES = 131072;
constexpr int LDSCTL_OFF = RING_BYTES, MISC_OFF = LDSCTL_OFF + 320;
constexpr int LDS_BYTES = 147456;
constexpr int RCACHE_OFF = MISC_OFF + 128;
constexpr int XCH_OFF = RCACHE_OFF + 8 * 528;
static_assert(XCH_OFF + 4096 <= LDS_BYTES && XCH_OFF % 16 == 0, "LDS map");
#define GAS __attribute__((address_space(1)))
#define LAS __attribute__((address_space(3)))
typedef unsigned short bf16;
typedef unsigned v4u __attribute__((ext_vector_type(4)));
typedef float f32x4 __attribute__((ext_vector_type(4)));
typedef short bf16x8 __attribute__((ext_vector_type(8)));
typedef GAS unsigned gu32;
typedef GAS unsigned long long gu64;
#define RLX_AGENT __ATOMIC_RELAXED, __HIP_MEMORY_SCOPE_AGENT
#define LDS_WAIT() asm volatile("s_waitcnt lgkmcnt(0)" ::: "memory")
#define VM_WAIT() asm volatile("s_waitcnt vmcnt(0)" ::: "memory")
__device__ __forceinline__ unsigned long long rt() { return __builtin_amdgcn_s_memrealtime(); }
__device__ __forceinline__ unsigned f2bf(float f) { unsigned u = __builtin_bit_cast(unsigned, f); return (u + 0x7fffu + ((u >> 16) & 1u)) >> 16; }
__device__ __forceinline__ unsigned pk2(float lo, float hi) { unsigned r; asm("v_cvt_pk_bf16_f32 %0, %1, %2" : "=v"(r) : "v"(lo), "v"(hi)); return r; }
#define XB_TMO      128
#define XB_XCNT(j)  (256  + 64 * (j))
#define XB_XSUB(j)  (1280 + 64 * (j))
#define XB_XGEN(j)  (2304 + 64 * (j))
#define XB_TOP      3328
#define XB_TOPGEN   3392
#define XCD_BAR_WORDS 3456
#define XB_SPIN_CAP (1u << 18)

__device__ __forceinline__ unsigned xb_ld(unsigned* p)              { return __hip_atomic_load(p, __ATOMIC_RELAXED, __HIP_MEMORY_SCOPE_AGENT); }
__device__ __forceinline__ unsigned xb_add(unsigned* p, unsigned v) { return __hip_atomic_fetch_add(p, v, __ATOMIC_RELAXED, __HIP_MEMORY_SCOPE_AGENT); }
__device__ __forceinline__ unsigned xb_xcc_id() { return (unsigned)__builtin_amdgcn_s_getreg((3 << 11) | 20) & 0xFu; }
#define XB_SPIN(cond, bar) do { unsigned _sp = 0; while (cond) { __builtin_amdgcn_s_sleep(1); \
    if ((++_sp & 255u) == 0u) { if (xb_ld(&(bar)[XB_TMO])) break; if (_sp > XB_SPIN_CAP) { atomicAdd(&(bar)[XB_TMO], 1u); break; } } } } while (0)

struct XcdBarrier {
    unsigned* bar; unsigned x;
    volatile LAS unsigned* st;
};

__device__ __forceinline__ XcdBarrier xcd_barrier_post(unsigned* bar, volatile LAS unsigned* st) {
    XcdBarrier b; b.bar = bar; b.x = xb_xcc_id(); b.st = st;
    if (threadIdx.x == 0) (void)xb_add(&bar[XB_XCNT(b.x)], 1u);
    return b;
}
__device__ __forceinline__ void xcd_barrier_complete(unsigned* bar, unsigned x, unsigned& nloc, unsigned& nx) {
    const unsigned G = gridDim.x * gridDim.y * gridDim.z;
    unsigned sum, cnt, mine, sp = 0u;
    for (;;) {
        sum = 0u; cnt = 0u; mine = 0u;
        unsigned cv[16];
#pragma unroll
        for (unsigned j = 0; j < 16; ++j) asm volatile("global_load_dword %0, %1, off sc1" : "=v"(cv[j]) : "v"(&bar[XB_XCNT(j)]) : "memory");
        asm volatile("s_waitcnt vmcnt(0)" : "+v"(cv[0]), "+v"(cv[1]), "+v"(cv[2]), "+v"(cv[3]), "+v"(cv[4]), "+v"(cv[5]), "+v"(cv[6]), "+v"(cv[7]) :: "memory");
        asm volatile("" : "+v"(cv[8]), "+v"(cv[9]), "+v"(cv[10]), "+v"(cv[11]), "+v"(cv[12]), "+v"(cv[13]), "+v"(cv[14]), "+v"(cv[15]));
#pragma unroll
        for (unsigned j = 0; j < 16; ++j) { const unsigned c = cv[j]; sum += c; cnt += (c > 0u) ? 1u : 0u; mine = (j == x) ? c : mine; }
        if (sum == G) break;
        __builtin_amdgcn_s_sleep(1);
        if ((++sp & 255u) == 0u) { if (xb_ld(&bar[XB_TMO])) break; if (sp > XB_SPIN_CAP) { atomicAdd(&bar[XB_TMO], 1u); break; } }
    }
    nloc = mine > 0u ? mine : 1u; nx = cnt > 0u ? cnt : 1u;
}

__device__ __forceinline__ void xcd_barrier(const XcdBarrier& b) {
    asm volatile("s_waitcnt vmcnt(0)" ::: "memory");
    __syncthreads();
    if (threadIdx.x == 0) {
        unsigned* bar = b.bar;
        __builtin_amdgcn_s_waitcnt(0);
        unsigned nloc = b.st[0], nx = b.st[1];
        if (nloc == 0u) { xcd_barrier_complete(bar, b.x, nloc, nx); b.st[0] = nloc; b.st[1] = nx; }
        const unsigned old = xb_add(&bar[XB_XSUB(b.x)], 1u);
        const unsigned gen = old / nloc;
        if (old + 1u == (gen + 1u) * nloc) {
            __builtin_amdgcn_fence(__ATOMIC_RELEASE, "agent");
            asm volatile("s_waitcnt vmcnt(0)" ::: "memory");
            const unsigned og = xb_add(&bar[XB_TOP], 1u);
            const unsigned tg = og / nx;
            if (og + 1u == (tg + 1u) * nx) xb_add(&bar[XB_TOPGEN], 1u);
            else XB_SPIN(xb_ld(&bar[XB_TOPGEN]) == tg, bar);
            __builtin_amdgcn_fence(__ATOMIC_ACQUIRE, "agent");
            xb_add(&bar[XB_XGEN(b.x)], 1u);
            asm volatile("s_waitcnt vmcnt(0)" ::: "memory");
        } else {
            XB_SPIN(xb_ld(&bar[XB_XGEN(b.x)]) == gen, bar);
            __builtin_amdgcn_fence(__ATOMIC_ACQUIRE, "agent");
            asm volatile("s_waitcnt vmcnt(0)" ::: "memory");
        }
    }
    __syncthreads();
}
typedef unsigned u32x2 __attribute__((ext_vector_type(2)));
__device__ __forceinline__ float wave_sum(float v) {
#pragma unroll
    for (int o = 1; o < 64; o <<= 1) v += __shfl_xor(v, o);
    return v;
}
__device__ __forceinline__ float wave_max(float v) {
#pragma unroll
    for (int o = 1; o < 64; o <<= 1) v = fmaxf(v, __shfl_xor(v, o));
    return v;
}
__device__ __forceinline__ float bf_lo(unsigned w) { return __uint_as_float(w << 16); }
__device__ __forceinline__ float bf_hi(unsigned w) { return __uint_as_float(w & 0xffff0000u); }
__device__ __forceinline__ float bf2f(bf16 h) { return __uint_as_float((unsigned)h << 16); }

#define CAS __attribute__((address_space(4)))
struct Args { const float* in[25]; float* out; unsigned char* ws; int ph_lo, ph_hi, li, pad; };
typedef const CAS Args* ArgsP;
__device__ __forceinline__ int local_tid() { int t = threadIdx.x; asm volatile("" : "+v"(t)); return t; }
__device__ __forceinline__ ArgsP phase_args() { ArgsP p = (ArgsP)__builtin_amdgcn_kernarg_segment_ptr(); asm volatile("" : "+s"(p)); return p; }
__device__ __forceinline__ float inv_freq_of(int i) { return exp2f(-(float)i * 0.4152410118609203f); }
__device__ __forceinline__ void rope_sincos(int pos, float inv_freq, float& sn, float& cs) {
    const float ang = (float)pos * inv_freq; double rv = (double)ang * 0.15915494309189535; rv -= rint(rv); const float fr = (float)rv;
    sn = __builtin_amdgcn_sinf(fr); cs = __builtin_amdgcn_cosf(fr);
}
namespace att {
typedef short bf16x8 __attribute__((ext_vector_type(8)));
typedef short s16x4 __attribute__((ext_vector_type(4)));
typedef float f32x16 __attribute__((ext_vector_type(16)));
typedef unsigned u32x4 __attribute__((ext_vector_type(4)));
constexpr int NW = 8, QBLK = 32, KVBLK = 64, QB = NW * QBLK;
constexpr int SHM_V = 16384, SHM_K = 16384, SHM_KR = 8192;
constexpr int OFF_V = 0, OFF_K = 2 * SHM_V, OFF_KR = OFF_K + 2 * SHM_K, OFF_WS = OFF_KR + 2 * SHM_KR, LDS_ATT = OFF_WS + NW * 256;
#define KSWZ(row, colB) ((row) * 256 + ((colB) ^ (((row) & 7) << 4)))
#define KRSWZ(row, colB) ((row) * 128 + ((colB) ^ ((((row) >> 1) & 7) << 4)))
__device__ __forceinline__ int v_st(int k, int c) { const int kk = (k & ~0xC) | ((k & 4) << 1) | ((k & 8) >> 1); return ((kk >> 3) * 4 + (c >> 5)) * 512 + ((kk & 7) * 32 + (c & 31)) * 2; }
__device__ __forceinline__ int v_rd_base(int lane) { return ((lane & 3) << 3) | (((lane >> 2) & 3) << 6) | (((lane >> 4) & 1) << 5) | (((lane >> 5) & 1) << 8); }
constexpr int v_rd_off(int d0, int ks, int half) { return d0 * 512 + ks * 4096 + half * 2048; }
__device__ __forceinline__ int crow(int r, int hi) { return (r & 3) + 8 * (r >> 2) + 4 * hi; }
__device__ __forceinline__ unsigned cvtpk(float lo, float hi) { unsigned r; asm volatile("v_cvt_pk_bf16_f32 %0, %1, %2" : "=v"(r) : "v"(lo), "v"(hi)); return r; }
#define ATT_SBAR() __builtin_amdgcn_sched_barrier(0)
#define ATT_PK4(P, B_, OUT) do { unsigned a0 = cvtpk(P[B_ + 0], P[B_ + 1]), a1 = cvtpk(P[B_ + 2], P[B_ + 3]); unsigned b0 = cvtpk(P[B_ + 4], P[B_ + 5]), b1 = cvtpk(P[B_ + 6], P[B_ + 7]); \
        auto r0 = __builtin_amdgcn_permlane32_swap(a0, b0, false, false); auto r1 = __builtin_amdgcn_permlane32_swap(a1, b1, false, false); \
        u32x4 w = {r0[0], r1[0], r0[1], r1[1]}; OUT = *reinterpret_cast<bf16x8*>(&w); } while (0)

template <int KB, int NQ>
__device__ __forceinline__ void qkt(f32x16& p0, f32x16& p1, LAS unsigned char* lds, int r32, int hi, const bf16x8* qr) {
    p0 = f32x16{}; p1 = f32x16{};
    LAS unsigned char* kb[4];
#pragma unroll
    for (int dd = 0; dd < 4; ++dd) kb[dd] = lds + OFF_K + KB * SHM_K + KSWZ(r32, (dd * 16 + hi * 8) * 2);
#pragma unroll
    for (int d0 = 0; d0 < 8; ++d0) { LAS unsigned char* a = kb[d0 & 3] + (d0 >> 2) * 128;
        const bf16x8 b0 = *(const LAS bf16x8*)a, b1 = *(const LAS bf16x8*)(a + 32 * 256);
        p0 = __builtin_amdgcn_mfma_f32_32x32x16_bf16(b0, qr[d0], p0, 0, 0, 0);
        p1 = __builtin_amdgcn_mfma_f32_32x32x16_bf16(b1, qr[d0], p1, 0, 0, 0); }
    if constexpr (NQ == 12) {
#pragma unroll
        for (int d0 = 0; d0 < 4; ++d0) { LAS unsigned char* a = lds + OFF_KR + KB * SHM_KR + KRSWZ(r32, (d0 * 16 + hi * 8) * 2);
            const bf16x8 b0 = *(const LAS bf16x8*)a, b1 = *(const LAS bf16x8*)(a + 32 * 128);
            p0 = __builtin_amdgcn_mfma_f32_32x32x16_bf16(b0, qr[8 + d0], p0, 0, 0, 0);
            p1 = __builtin_amdgcn_mfma_f32_32x32x16_bf16(b1, qr[8 + d0], p1, 0, 0, 0); } }
}
template <int VB>
__device__ __forceinline__ void pv_tile(f32x16* o, int vb0, bf16x8 pa0, bf16x8 pa1, bf16x8 pa2, bf16x8 pa3) {
#define ATT_TRRD(dst, off) asm volatile("ds_read_b64_tr_b16 %0, %1 offset:%2" : "=&v"(dst) : "v"(vb0), "i"(off) : "memory")
#define ATT_PV_D0(d0) do { s16x4 l0, l1, l2, l3, h0, h1, h2, h3; constexpr int b_ = OFF_V + VB * SHM_V + v_rd_off(d0, 0, 0); \
        ATT_TRRD(l0, b_); ATT_TRRD(h0, b_ + 2048); ATT_TRRD(l1, b_ + 4096); ATT_TRRD(h1, b_ + 6144); ATT_TRRD(l2, b_ + 8192); ATT_TRRD(h2, b_ + 10240); ATT_TRRD(l3, b_ + 12288); ATT_TRRD(h3, b_ + 14336); \
        asm volatile("s_waitcnt lgkmcnt(0)" ::: "memory"); ATT_SBAR(); \
        o[d0] = __builtin_amdgcn_mfma_f32_32x32x16_bf16((bf16x8){l0[0], l0[1], l0[2], l0[3], h0[0], h0[1], h0[2], h0[3]}, pa0, o[d0], 0, 0, 0); \
        o[d0] = __builtin_amdgcn_mfma_f32_32x32x16_bf16((bf16x8){l1[0], l1[1], l1[2], l1[3], h1[0], h1[1], h1[2], h1[3]}, pa1, o[d0], 0, 0, 0); \
        o[d0] = __builtin_amdgcn_mfma_f32_32x32x16_bf16((bf16x8){l2[0], l2[1], l2[2], l2[3], h2[0], h2[1], h2[2], h2[3]}, pa2, o[d0], 0, 0, 0); \
        o[d0] = __builtin_amdgcn_mfma_f32_32x32x16_bf16((bf16x8){l3[0], l3[1], l3[2], l3[3], h3[0], h3[1], h3[2], h3[3]}, pa3, o[d0], 0, 0, 0); } while (0)
    ATT_PV_D0(0); ATT_PV_D0(1); ATT_PV_D0(2); ATT_PV_D0(3);
#undef ATT_PV_D0
#undef ATT_TRRD
}


__device__ __forceinline__ void softmax_step(f32x16& p0, f32x16& p1, int kb, int qlo, int qpos, int hi, float scale, float& m_reg, float& l_reg, f32x16* o,
                                             bf16x8& pa0, bf16x8& pa1, bf16x8& pa2, bf16x8& pa3) {
    const float C2 = scale * 1.4426950408889634f;
    if (kb + KVBLK - 1 > qlo) {
        const int dq = qpos - kb - 4 * hi; const float NEG = -__builtin_inff();
#pragma unroll
        for (int r = 0; r < 16; ++r) { const int c = (r & 3) + 8 * (r >> 2); if (c > dq) p0[r] = NEG; if (c + 32 > dq) p1[r] = NEG; }
    }
    float pmax = p0[0];
#pragma unroll
    for (int r = 1; r < 16; ++r) pmax = fmaxf(pmax, p0[r]);
#pragma unroll
    for (int r = 0; r < 16; ++r) pmax = fmaxf(pmax, p1[r]);
    { auto rr = __builtin_amdgcn_permlane32_swap(__float_as_uint(pmax), __float_as_uint(pmax), false, false); pmax = fmaxf(__uint_as_float(rr[0]), __uint_as_float(rr[1])); }
    const float mn = fmaxf(m_reg, pmax), alpha = __builtin_amdgcn_exp2f((m_reg - mn) * C2), mnL = -mn * C2; m_reg = mn;
    float ps = 0.f;
#pragma unroll
    for (int r = 0; r < 16; ++r) { p0[r] = __builtin_amdgcn_exp2f(fmaf(p0[r], C2, mnL)); ps += p0[r]; }
#pragma unroll
    for (int r = 0; r < 16; ++r) { p1[r] = __builtin_amdgcn_exp2f(fmaf(p1[r], C2, mnL)); ps += p1[r]; }
    { auto rr = __builtin_amdgcn_permlane32_swap(__float_as_uint(ps), __float_as_uint(ps), false, false); ps = __uint_as_float(rr[0]) + __uint_as_float(rr[1]); }
    l_reg = l_reg * alpha + ps;
    if (__any(alpha < 1.f)) {
#pragma unroll
        for (int d = 0; d < 4; ++d)
#pragma unroll
            for (int r = 0; r < 16; ++r) o[d][r] *= alpha;
    }
    ATT_PK4(p0, 0, pa0); ATT_PK4(p0, 8, pa1); ATT_PK4(p1, 0, pa2); ATT_PK4(p1, 8, pa3);
}
__device__ __forceinline__ void sb_step(f32x16& p0, f32x16& p1, int kb, int qlo, int qpos, int hi, float scale, float& carry, bf16x8& pa0, bf16x8& pa1, bf16x8& pa2, bf16x8& pa3) {
    const float NC = -scale * 1.4426950408889634f;
    f32x16 k0, k1;
#pragma unroll
    for (int r = 0; r < 16; ++r) { const float t = __builtin_amdgcn_exp2f(fminf(fmaxf(p0[r] * NC, -115.f), 115.f)); const float b = __builtin_amdgcn_rcpf(1.0f + t); p0[r] = b; k0[r] = t * b; }
#pragma unroll
    for (int r = 0; r < 16; ++r) { const float t = __builtin_amdgcn_exp2f(fminf(fmaxf(p1[r] * NC, -115.f), 115.f)); const float b = __builtin_amdgcn_rcpf(1.0f + t); p1[r] = b; k1[r] = t * b; }
    if (kb + KVBLK - 1 >= qlo) {
        const int dq = qpos - kb - 4 * hi;
#pragma unroll
        for (int r = 0; r < 16; ++r) { const int c = (r & 3) + 8 * (r >> 2); if (!(c < dq)) { p0[r] = 0.f; k0[r] = 1.f; } if (!(c + 32 < dq)) { p1[r] = 0.f; k1[r] = 1.f; } }
    }
    float T[8], Hown[8];
#pragma unroll
    for (int g = 0; g < 4; ++g) { T[g] = (k0[4 * g] * k0[4 * g + 1]) * (k0[4 * g + 2] * k0[4 * g + 3]); T[4 + g] = (k1[4 * g] * k1[4 * g + 1]) * (k1[4 * g + 2] * k1[4 * g + 3]); }
    float H = carry;
#pragma unroll
    for (int g = 7; g >= 0; --g) { auto rr = __builtin_amdgcn_permlane32_swap(__float_as_uint(T[g]), __float_as_uint(T[g]), false, false);
        const float e0 = __uint_as_float(rr[0]), e1 = __uint_as_float(rr[1]);
        const float H0 = H * e1; Hown[g] = hi ? H : H0; H = H0 * e0; }
    carry = H;
#pragma unroll
    for (int g = 0; g < 4; ++g) {
        { const float c3 = Hown[g], c2 = c3 * k0[4 * g + 3], c1 = c2 * k0[4 * g + 2], c0 = c1 * k0[4 * g + 1]; p0[4 * g + 3] *= c3; p0[4 * g + 2] *= c2; p0[4 * g + 1] *= c1; p0[4 * g] *= c0; }
        { const float c3 = Hown[4 + g], c2 = c3 * k1[4 * g + 3], c1 = c2 * k1[4 * g + 2], c0 = c1 * k1[4 * g + 1]; p1[4 * g + 3] *= c3; p1[4 * g + 2] *= c2; p1[4 * g + 1] *= c1; p1[4 * g] *= c0; }
    }
    ATT_PK4(p0, 0, pa0); ATT_PK4(p0, 8, pa1); ATT_PK4(p1, 0, pa2); ATT_PK4(p1, 8, pa3);
}

template <int MODE>
__device__ __forceinline__ void attn_unit(LAS unsigned char* lds, const bf16* Q, int ldq, const bf16* K, int ldk, const bf16* KR, const bf16* V, int ldv, void* O_, int ldo, int P0, float scale,
                                          const float* gq = nullptr, const float* gk = nullptr, const float* ssqx = nullptr, const int* posq = nullptr, float* osq = nullptr) {
    constexpr int NQ = (MODE == 0) ? 12 : 8;
    const int tid = local_tid(), wid = __builtin_amdgcn_readfirstlane(tid >> 6), lane = tid & 63, r32 = lane & 31, hi = lane >> 5;
    const int NT = (MODE == 1) ? 4 : P0 / KVBLK + 4;
    const int qlo = (MODE == 1) ? (1 << 28) : P0 + wid * QBLK, qpos = qlo + r32;
    if (wid >= 4) __builtin_amdgcn_s_setprio(1);
    float gkv[8];
    if constexpr (MODE == 1) { const GAS f32x4* gp = (const GAS f32x4*)(gk + (tid & 15) * 8); const f32x4 g0 = gp[0], g1 = gp[1];
#pragma unroll
        for (int j = 0; j < 4; ++j) { gkv[j] = g0[j]; gkv[4 + j] = g1[j]; } }
    const int sr = tid >> 4, sc = (tid & 15) * 8, kws = KSWZ(sr, sc * 2), vst0 = v_st(sr, sc), vst1 = v_st(32 + sr, sc);
    const int krr = tid >> 3, krc = (tid & 7) * 8, krws = KRSWZ(krr, krc * 2);
    const int vb0 = (int)(size_t)lds + v_rd_base(lane);
    bf16x8 st_k0, st_k1, st_v0, st_v1, st_kr;
#define ATT_LOAD(kb) do { st_k0 = *(const GAS bf16x8*)(K + (size_t)((kb) + sr) * ldk + sc); st_k1 = *(const GAS bf16x8*)(K + (size_t)((kb) + 32 + sr) * ldk + sc); \
        st_v0 = *(const GAS bf16x8*)(V + (size_t)((kb) + sr) * ldv + sc); st_v1 = *(const GAS bf16x8*)(V + (size_t)((kb) + 32 + sr) * ldv + sc); \
        if constexpr (MODE == 0) st_kr = *(const GAS bf16x8*)(KR + (size_t)((kb) + krr) * 64 + krc); } while (0)
#define ATT_WRITE(bf) do { *(LAS bf16x8*)(lds + OFF_K + (bf) * SHM_K + kws) = st_k0; *(LAS bf16x8*)(lds + OFF_K + (bf) * SHM_K + kws + 32 * 256) = st_k1; \
        *(LAS bf16x8*)(lds + OFF_V + (bf) * SHM_V + vst0) = st_v0; *(LAS bf16x8*)(lds + OFF_V + (bf) * SHM_V + vst1) = st_v1; \
        if constexpr (MODE == 0) *(LAS bf16x8*)(lds + OFF_KR + (bf) * SHM_KR + krws) = st_kr; } while (0)
#define ATT_KNORM1(S_) do { float v_[8], ss_ = 0.f; _Pragma("unroll") for (int j = 0; j < 8; ++j) { v_[j] = bf2f((bf16)S_[j]); ss_ += v_[j] * v_[j]; } \
        ss_ += __shfl_xor(ss_, 1); ss_ += __shfl_xor(ss_, 2); ss_ += __shfl_xor(ss_, 4); ss_ += __shfl_xor(ss_, 8);        \
        const float ri_ = rsqrtf(ss_ * (1.0f / 128.0f) + 1e-6f); _Pragma("unroll") for (int j = 0; j < 8; ++j) v_[j] *= ri_ * gkv[j]; \
        u32x4 w_ = {cvtpk(v_[0], v_[1]), cvtpk(v_[2], v_[3]), cvtpk(v_[4], v_[5]), cvtpk(v_[6], v_[7])}; S_ = *reinterpret_cast<bf16x8*>(&w_); } while (0)
#define ATT_KNORM() do { if constexpr (MODE == 1) { ATT_KNORM1(st_k0); ATT_KNORM1(st_k1); } } while (0)
#define ATT_KB(t) (((MODE == 2) ? (NT - 1 - (t)) : (t)) * KVBLK)
    ATT_LOAD(ATT_KB(0));
    bf16x8 qr[NQ];
    if constexpr (MODE != 1) { const bf16* qrow = Q + (size_t)(wid * QBLK + r32) * ldq;
#pragma unroll
      for (int d0 = 0; d0 < NQ; ++d0) qr[d0] = *(const GAS bf16x8*)(qrow + d0 * 16 + hi * 8); }
    else if (wid < 4) {
        const GAS bf16* qrow = (const GAS bf16*)Q + (size_t)(wid * QBLK + r32) * ldq; f32x4 qa[8][2];
        u32x4 qw[4][8];
#pragma unroll
        for (int ks = 0; ks < 4; ++ks)
#pragma unroll
            for (int d0 = 0; d0 < 8; ++d0) qw[ks][d0] = *(const GAS u32x4*)(qrow + (size_t)ks * T * XW + d0 * 16 + hi * 8);
#pragma unroll
        for (int d0 = 0; d0 < 8; ++d0) {
#pragma unroll
            for (int ks = 0; ks < 4; ++ks) { const u32x4 w = qw[ks][d0];
                const f32x4 a = {__uint_as_float(w.x << 16), __uint_as_float(w.x & 0xffff0000u), __uint_as_float(w.y << 16), __uint_as_float(w.y & 0xffff0000u)};
                const f32x4 b = {__uint_as_float(w.z << 16), __uint_as_float(w.z & 0xffff0000u), __uint_as_float(w.w << 16), __uint_as_float(w.w & 0xffff0000u)};
                if (ks == 0) { qa[d0][0] = a; qa[d0][1] = b; } else { qa[d0][0] += a; qa[d0][1] += b; } } }
        f32x4 gx[8][2];
#pragma unroll
        for (int d0 = 0; d0 < 8; ++d0) { const GAS f32x4* gp = (const GAS f32x4*)(gq + d0 * 16 + hi * 8); gx[d0][0] = gp[0]; gx[d0][1] = gp[1]; }
        float sx = 0.f;
        { const GAS f32x4* sp = (const GAS f32x4*)(ssqx + (size_t)(wid * QBLK + r32) * 64 + hi * 32);
#pragma unroll
          for (int i = 0; i < 8; ++i) { const f32x4 v = sp[i]; sx += (v[0] + v[1]) + (v[2] + v[3]); } }
        { auto rr = __builtin_amdgcn_permlane32_swap(__float_as_uint(sx), __float_as_uint(sx), false, false); sx = __uint_as_float(rr[0]) + __uint_as_float(rr[1]); }
        const float rx = rsqrtf(sx * (1.0f / 4096.0f) + 1e-6f);
        float ss = 0.f;
#pragma unroll
        for (int d0 = 0; d0 < 8; ++d0) { qa[d0][0] *= rx; qa[d0][1] *= rx; ss += ((qa[d0][0][0] * qa[d0][0][0] + qa[d0][0][1] * qa[d0][0][1]) + (qa[d0][0][2] * qa[d0][0][2] + qa[d0][0][3] * qa[d0][0][3]))
                                                                                 + ((qa[d0][1][0] * qa[d0][1][0] + qa[d0][1][1] * qa[d0][1][1]) + (qa[d0][1][2] * qa[d0][1][2] + qa[d0][1][3] * qa[d0][1][3])); }
        { auto rr = __builtin_amdgcn_permlane32_swap(__float_as_uint(ss), __float_as_uint(ss), false, false); ss = __uint_as_float(rr[0]) + __uint_as_float(rr[1]); }
        const float ri = rsqrtf(ss * (1.0f / 128.0f) + 1e-6f);
#pragma unroll
        for (int d0 = 0; d0 < 8; ++d0) { const f32x4 v0 = qa[d0][0] * ri * gx[d0][0], v1 = qa[d0][1] * ri * gx[d0][1];
            u32x4 w = {cvtpk(v0[0], v0[1]), cvtpk(v0[2], v0[3]), cvtpk(v1[0], v1[1]), cvtpk(v1[2], v1[3])}; qr[d0] = *reinterpret_cast<bf16x8*>(&w); }
    }
    if constexpr (MODE == 0) {
        f32x4 gn[8][2], gr[2][4];
#pragma unroll
        for (int d0 = 0; d0 < 8; ++d0) { const GAS f32x4* gp = (const GAS f32x4*)(gq + d0 * 16 + hi * 8); gn[d0][0] = gp[0]; gn[d0][1] = gp[1]; }
#pragma unroll
        for (int dd = 0; dd < 2; ++dd) { const int i0 = 16 * dd + 8 * hi; const GAS f32x4* g1p = (const GAS f32x4*)(gq + 128 + i0); const GAS f32x4* g2p = (const GAS f32x4*)(gq + 160 + i0);
            gr[dd][0] = g1p[0]; gr[dd][1] = g1p[1]; gr[dd][2] = g2p[0]; gr[dd][3] = g2p[1]; }
        int pos = posq[wid * QBLK + r32];
        float sn_ = 0.f, sr_ = 0.f;
#pragma unroll
        for (int d0 = 0; d0 < 12; ++d0)
#pragma unroll
            for (int j = 0; j < 8; ++j) { const float v = bf2f((bf16)qr[d0][j]); if (d0 < 8) sn_ += v * v; else sr_ += v * v; }
        { auto rr = __builtin_amdgcn_permlane32_swap(__float_as_uint(sn_), __float_as_uint(sn_), false, false); sn_ = __uint_as_float(rr[0]) + __uint_as_float(rr[1]); }
        { auto rr = __builtin_amdgcn_permlane32_swap(__float_as_uint(sr_), __float_as_uint(sr_), false, false); sr_ = __uint_as_float(rr[0]) + __uint_as_float(rr[1]); }
        asm volatile("" : "+v"(pos));
        const float rn = rsqrtf(sn_ * (1.0f / 128.0f) + 1e-6f), rr_ = rsqrtf(sr_ * (1.0f / 64.0f) + 1e-6f);
#pragma unroll
        for (int d0 = 0; d0 < 8; ++d0) { const f32x4 g0 = gn[d0][0], g1 = gn[d0][1]; float v[8];
#pragma unroll
            for (int j = 0; j < 8; ++j) v[j] = bf2f((bf16)qr[d0][j]) * rn * (j < 4 ? g0[j] : g1[j - 4]);
            u32x4 w = {cvtpk(v[0], v[1]), cvtpk(v[2], v[3]), cvtpk(v[4], v[5]), cvtpk(v[6], v[7])}; qr[d0] = *reinterpret_cast<bf16x8*>(&w); }
#pragma unroll
        for (int dd = 0; dd < 2; ++dd) { const int i0 = 16 * dd + 8 * hi; float o1[8], o2[8];
            const f32x4 ga0 = gr[dd][0], ga1 = gr[dd][1], gb0 = gr[dd][2], gb1 = gr[dd][3];
#pragma unroll
            for (int j = 0; j < 8; ++j) { float sn, cs; rope_sincos(pos, inv_freq_of(i0 + j), sn, cs);
                const float x1 = bf2f((bf16)qr[8 + dd][j]) * rr_ * (j < 4 ? ga0[j] : ga1[j - 4]), x2 = bf2f((bf16)qr[10 + dd][j]) * rr_ * (j < 4 ? gb0[j] : gb1[j - 4]);
                o1[j] = x1 * cs - x2 * sn; o2[j] = x1 * sn + x2 * cs; }
            u32x4 w1 = {cvtpk(o1[0], o1[1]), cvtpk(o1[2], o1[3]), cvtpk(o1[4], o1[5]), cvtpk(o1[6], o1[7])}; qr[8 + dd] = *reinterpret_cast<bf16x8*>(&w1);
            u32x4 w2 = {cvtpk(o2[0], o2[1]), cvtpk(o2[2], o2[3]), cvtpk(o2[4], o2[5]), cvtpk(o2[6], o2[7])}; qr[10 + dd] = *reinterpret_cast<bf16x8*>(&w2); }
    }
    float m_reg = -1e30f, l_reg = 0.f, carry = 1.f; f32x16 o[4] = {};
    f32x16 p0, p1; bf16x8 pa0, pa1, pa2, pa3;
    asm volatile("s_waitcnt vmcnt(0)" ::: "memory"); ATT_KNORM(); ATT_WRITE(0);
    __syncthreads();
#define ATT_STEP(t, BF) do { const int kb_ = ATT_KB(t); const bool more_ = (t) + 1 < NT; \
        if (more_) ATT_LOAD(ATT_KB((t) + 1)); \
        if ((MODE != 1 || wid < 4) && kb_ <= qlo + QBLK - 1) {                   \
            ATT_SBAR(); qkt<BF, NQ>(p0, p1, lds, r32, hi, qr); \
            if constexpr (MODE != 2) softmax_step(p0, p1, kb_, qlo, qpos, hi, scale, m_reg, l_reg, o, pa0, pa1, pa2, pa3); \
            else sb_step(p0, p1, kb_, qlo, qpos, hi, scale, carry, pa0, pa1, pa2, pa3); \
            ATT_SBAR(); pv_tile<BF>(o, vb0, pa0, pa1, pa2, pa3); } \
        if (more_) { asm volatile("s_waitcnt vmcnt(0)" ::: "memory"); ATT_KNORM(); ATT_WRITE((BF) ^ 1); } \
        if constexpr (MODE == 2) { if (lane == 0) xflag[(BF) * 8 + wid] = __all(carry == 0.f) ? 1u : 0u; }     \
        __syncthreads(); \
        if constexpr (MODE == 2) { stop_ = __all(xflag[(BF) * 8 + (lane & 7)] != 0u); } } while (0)
    LAS unsigned* xflag = (LAS unsigned*)(lds + LDS_ATT); bool stop_ = false;
    for (int t = 0; t < NT; t += 2) { ATT_STEP(t, 0); if (stop_) break; ATT_STEP(t + 1, 1); if (stop_) break; }
    if (MODE != 1 || wid < 4) { float rl = 1.0f; if constexpr (MODE != 2) rl = __builtin_amdgcn_rcpf(l_reg);
      float sq = 0.f; bf16* orow = (bf16*)O_ + (size_t)(wid * QBLK + r32) * ldo + hi * 8;
#pragma unroll
      for (int d0 = 0; d0 < 4; ++d0)
#pragma unroll
          for (int gp = 0; gp < 2; ++gp) { float a[4], b[4];
#pragma unroll
              for (int i = 0; i < 4; ++i) { a[i] = o[d0][8 * gp + i] * rl; b[i] = o[d0][8 * gp + 4 + i] * rl; sq += a[i] * a[i] + b[i] * b[i]; }
              const unsigned ax = cvtpk(a[0], a[1]), ay = cvtpk(a[2], a[3]), bx = cvtpk(b[0], b[1]), by = cvtpk(b[2], b[3]);
              auto rx = __builtin_amdgcn_permlane32_swap(ax, bx, false, false); auto ry = __builtin_amdgcn_permlane32_swap(ay, by, false, false);
              u32x4 w = {rx[0], ry[0], rx[1], ry[1]};
              *(GAS u32x4*)(orow + d0 * 32 + gp * 16) = w; }
      if constexpr (MODE != 1) { auto rr = __builtin_amdgcn_permlane32_swap(__float_as_uint(sq), __float_as_uint(sq), false, false); sq = __uint_as_float(rr[0]) + __uint_as_float(rr[1]);
          if (hi == 0) osq[(size_t)(wid * QBLK + r32) * 32] = sq; } }
    __syncthreads();
    __builtin_amdgcn_s_setprio(0);
#undef ATT_STEP
#undef ATT_KB
#undef ATT_KNORM
#undef ATT_KNORM1
#undef ATT_WRITE
#undef ATT_LOAD
}
}

__device__ __forceinline__ void p_attn_mfma(ArgsP P, int l, LAS unsigned char* lds) {
    unsigned char* ws = P->ws; const int G = gridDim.x;
    bf16* Ob = (bf16*)(ws + WS_MIXED); float* Osq = (float*)(ws + WS_SSQO);
    const float* gq = P->in[9] + l * QKD; const float* gk = P->in[10] + l * QKD; const int* pos = (const int*)P->in[2];
    for (int it = blockIdx.x; it < 256; it += G)
        for (int pass = 0; pass < 2; ++pass) {
            const int bh = it >> 2, pr = it & 3, b = bh >> 4, h = bh & 15, qb = pass ? 7 - pr : pr; const size_t row0 = (size_t)b * SEQ + qb * 256, key0 = (size_t)b * SEQ;
            att::attn_unit<0>(lds, (const bf16*)(ws + WS_QRAW) + row0 * QUP_N + h * QKD, QUP_N, (const bf16*)(ws + WS_KVRAW) + key0 * KVUP_N + h * 256, KVUP_N, (const bf16*)(ws + WS_KRN) + key0 * 64,
                              (const bf16*)(ws + WS_KVRAW) + key0 * KVUP_N + h * 256 + 128, KVUP_N, Ob + row0 * DM + h * 128, DM, qb * 256, 0.07216878364870322f, gq, gk, nullptr, pos + row0, Osq + row0 * 32 + h);
        }
    for (int it = blockIdx.x; it < 256; it += G)
        for (int pass = 0; pass < 2; ++pass) {
            const int bh = it >> 2, pr = it & 3, b = bh >> 4, h = bh & 15, qb = pass ? 7 - pr : pr; const size_t row0 = (size_t)b * SEQ + qb * 256, key0 = (size_t)b * SEQ;
            att::attn_unit<2>(lds, (const bf16*)(ws + WS_QSB) + row0 * SBW + h * 128, SBW, (const bf16*)(ws + WS_KSB) + key0 * SBW + h * 128, SBW, nullptr,
                              (const bf16*)(ws + WS_VSB) + key0 * SBW + h * 128, SBW, Ob + row0 * DM + 2048 + h * 128, DM, qb * 256, 0.08838834764831845f, nullptr, nullptr, nullptr, nullptr, Osq + row0 * 32 + 16 + h);
        }
}

__device__ __forceinline__ void p_xattn_mfma(ArgsP P, int l, LAS unsigned char* lds) {
    unsigned char* ws = P->ws; const int G = gridDim.x; const float* gq = P->in[18] + l * 128; const float* gk = P->in[19] + l * 128;
    for (int it = blockIdx.x; it < 256; it += G) {
        const int bh = it >> 4, qb = (it >> 1) & 7, b = bh >> 2, h = bh & 3; const size_t row0 = (size_t)b * SEQ + qb * 256 + (it & 1) * 128;
        const bf16* KV = (const bf16*)(ws + WS_KVX) + (size_t)l * TMEM * 1024 + (size_t)b * MEMLEN * 1024 + h * 256;
        att::attn_unit<1>(lds, (const bf16*)(ws + WS_QX) + row0 * XW + h * 128, XW, KV, 1024, nullptr, KV + 128, 1024, (bf16*)(ws + WS_OX) + row0 * XW + h * 128, XW, 0, 0.08838834764831845f, gq, gk,
                          (const float*)(ws + WS_SSQX) + ((size_t)(l * 3 + 1) * T + row0) * 64);
    }
}


struct TrD { const float* W; const float* g; bf16* WT; size_t ldk; int N, d0, kdst0, k0, n0; };
__device__ __forceinline__ void tr_dma_item(const TrD& D, LAS unsigned char* buf, int lane) {
    const char* gb = (const char*)(D.W + (size_t)D.k0 * D.N + D.n0);
    const unsigned rowoff = (unsigned)(lane >> 4) * (unsigned)D.N * 4u;
#pragma unroll
    for (int q = 0; q < 16; ++q) { const unsigned lo = rowoff + (unsigned)(((lane & 15) ^ ((q >> 1) & 7)) << 4);
        __builtin_amdgcn_global_load_lds((const unsigned*)(gb + (size_t)(4 * q) * D.N * 4 + lo), (LAS unsigned*)(buf + q * 1024), 16, 0, 2); }
    const int c = lane & 7, nr = lane >> 3;
    f32x4 ga = {1.f, 1.f, 1.f, 1.f}, gb4 = {1.f, 1.f, 1.f, 1.f};
    if (D.g) { ga = *(const GAS f32x4*)(D.g + D.k0 + 8 * c); gb4 = *(const GAS f32x4*)(D.g + D.k0 + 8 * c + 4); }
    asm volatile("s_waitcnt vmcnt(0)" ::: "memory");
    const int a0 = (int)(size_t)buf + 8 * c * 256 + (nr & 3) * 4, ce = c ^ (nr >> 2);
#pragma unroll
    for (int jj = 0; jj < 8; ++jj) { const int n = nr + 8 * jj; const LAS float* p = (const LAS float*)(size_t)(unsigned)(a0 + (((2 * jj) ^ ce) << 4));
        const float v0 = p[0] * ga[0], v1 = p[64] * ga[1], v2 = p[128] * ga[2], v3 = p[192] * ga[3], v4 = p[256] * gb4[0], v5 = p[320] * gb4[1], v6 = p[384] * gb4[2], v7 = p[448] * gb4[3];
        v4u o; o.x = pk2(v0, v1); o.y = pk2(v2, v3); o.z = pk2(v4, v5); o.w = pk2(v6, v7);
        *(GAS v4u*)(D.WT + (size_t)(D.d0 + n) * D.ldk + D.kdst0 + 8 * c) = o; }
    LDS_WAIT(); asm volatile("" ::: "memory");
}
template <int MAP>
__device__ __forceinline__ void tr_set(TrD& D, const float* W, int K, int N, const float* g, bf16* WT, size_t ldk, int kdst_off, int r) {
    const int nblk = N / 64, kb = (r & 3) + 4 * (r / (4 * nblk)), nb = (r >> 2) % nblk, k0 = 64 * kb, n0 = 64 * nb;
    int d0 = n0;
    if (MAP == 1) d0 = (n0 < 1536) ? n0 : (n0 < 1600 ? 7680 + (n0 - 1536) : n0 - 64);
    if (MAP == 2) d0 = (n0 >> 7) * 256 + (n0 & 127);
    if (MAP == 3) d0 = (n0 >> 7) * 256 + 128 + (n0 & 127);
    D.W = W; D.g = g; D.WT = WT; D.ldk = ldk; D.N = N; D.d0 = d0; D.kdst0 = kdst_off + k0; D.k0 = k0; D.n0 = n0;
}
__device__ __forceinline__ void row_to_bf16_ssq(const float* xrow, bf16* orow, float* ssq64, int lane) {
    const GAS f32x4* xr = (const GAS f32x4*)xrow + lane; GAS u32x2* o8 = (GAS u32x2*)orow + lane; float s = 0.f;
#pragma unroll 16
    for (int j = 0; j < 16; ++j) { const f32x4 v = xr[64 * j]; s += (v.x * v.x + v.y * v.y) + (v.z * v.z + v.w * v.w); u32x2 w; w.x = pk2(v.x, v.y); w.y = pk2(v.z, v.w); o8[64 * j] = w; }
    ssq64[lane] = s;
}
constexpr int I_IN = (DM / 64) * (IN_COLS / 64), I_QUP = (QRANK / 64) * (QUP_N / 64), I_KVUP = (KVRANK / 64) * (KVUP_N / 64), I_OUTH = (2048 / 64) * (DM / 64);
constexpr int I_XQ = (DM / 64) * (XW / 64), I_XKV = (DM / 64) * (1024 / 64), I_XO = (XW / 64) * (DM / 64), I_G = (DM / 64) * (FF / 64), I_DN = (FF / 64) * (DM / 64);
constexpr int I_LAYER = I_IN + I_QUP + I_KVUP + 2 * I_OUTH + I_XQ + I_XKV + I_XO + 2 * I_G + I_DN;
constexpr int I_XKV0 = I_IN + I_QUP + I_KVUP + 2 * I_OUTH + I_XQ;
__device__ __forceinline__ void conv_items(ArgsP P, LAS unsigned char* lds, int a0, int a1, int b0, int b1) {
    const int tid = local_tid(), lane = tid & 63, wave = __builtin_amdgcn_readfirstlane(tid >> 6), gw = blockIdx.x * NWAVES + wave, NGW = gridDim.x * NWAVES;
    unsigned char* ws = P->ws; const int n0 = a1 - a0, ntot = n0 + (b1 - b0);
    auto desc = [&](int v, TrD& D) { const int it = v < n0 ? a0 + v : b0 + (v - n0);
        const int l = it / I_LAYER; int r = it % I_LAYER; unsigned char* wl = ws + WS_W + (size_t)l * WL_BYTES;
        if (r < I_IN) { tr_set<1>(D, P->in[4] + (size_t)l * DM * IN_COLS, DM, IN_COLS, P->in[3] + l * DM, (bf16*)(wl + WL_IN), DM, 0, r); return; } r -= I_IN;
        if (r < I_QUP) { tr_set<0>(D, P->in[7] + (size_t)l * QRANK * QUP_N, QRANK, QUP_N, P->in[5] + l * QRANK, (bf16*)(wl + WL_QUP), QRANK, 0, r); return; } r -= I_QUP;
        if (r < I_KVUP) { tr_set<0>(D, P->in[8] + (size_t)l * KVRANK * KVUP_N, KVRANK, KVUP_N, P->in[6] + l * KVRANK, (bf16*)(wl + WL_KVUP), KVRANK, 0, r); return; } r -= I_KVUP;
        if (r < I_OUTH) { tr_set<0>(D, P->in[13] + (size_t)l * DM * DM, 2048, DM, P->in[11] + l * 2048, (bf16*)(wl + WL_OUT), DM, 0, r); return; } r -= I_OUTH;
        if (r < I_OUTH) { tr_set<0>(D, P->in[13] + (size_t)l * DM * DM + (size_t)2048 * DM, 2048, DM, P->in[12] + l * 2048, (bf16*)(wl + WL_OUT), DM, 2048, r); return; } r -= I_OUTH;
        if (r < I_XQ) { tr_set<0>(D, P->in[16] + (size_t)l * DM * XW, DM, XW, P->in[14] + l * DM, (bf16*)(wl + WL_XQ), DM, 0, r); return; } r -= I_XQ;
        if (r < I_XKV) { tr_set<0>(D, P->in[17] + (size_t)l * DM * 1024, DM, 1024, P->in[15] + l * DM, (bf16*)(wl + WL_XKV), DM, 0, r); return; } r -= I_XKV;
        if (r < I_XO) { tr_set<0>(D, P->in[20] + (size_t)l * XW * DM, XW, DM, nullptr, (bf16*)(wl + WL_XO), XW, 0, r); return; } r -= I_XO;
        if (r < I_G) { tr_set<2>(D, P->in[22] + (size_t)l * DM * FF, DM, FF, P->in[21] + l * DM, (bf16*)(wl + WL_GU), DM, 0, r); return; } r -= I_G;
        if (r < I_G) { tr_set<3>(D, P->in[23] + (size_t)l * DM * FF, DM, FF, P->in[21] + l * DM, (bf16*)(wl + WL_GU), DM, 0, r); return; } r -= I_G;
        tr_set<0>(D, P->in[24] + (size_t)l * FF * DM, FF, DM, nullptr, (bf16*)(wl + WL_DN), FF, 0, r);
    };
    LAS unsigned char* buf = lds + RING_OFF + wave * 16384;
    for (int v = gw; v < ntot; v += NGW) { TrD D; desc(v, D); tr_dma_item(D, buf, lane); }
}
__device__ __forceinline__ void p0_prologue(ArgsP P, LAS unsigned char* lds) {
    conv_items(P, lds, 0, I_IN, I_XKV0, I_XKV0 + I_XKV);
    const int tid = local_tid(), lane = tid & 63, wave = __builtin_amdgcn_readfirstlane(tid >> 6), gw = blockIdx.x * NWAVES + wave, NGW = gridDim.x * NWAVES;
    unsigned char* ws = P->ws;
    for (int c = gw * 64 + lane; c < DEPTH * 98304; c += NGW * 64) { const int l = c / 98304, cc = c % 98304;
        *(GAS v4u*)(ws + WS_W + (size_t)l * WL_BYTES + WL_IN + (size_t)IN_COLS * DM * 2 + (size_t)cc * 16) = (v4u){0u, 0u, 0u, 0u}; }
    for (int m = gw; m < T + TMEM; m += NGW) {
        if (m < T) row_to_bf16_ssq(P->in[0] + (size_t)m * DM, (bf16*)(ws + WS_XB) + (size_t)m * DM, (float*)(ws + WS_SSQX) + (size_t)m * 64, lane);
        else { const int mm = m - T; row_to_bf16_ssq(P->in[1] + (size_t)mm * DM, (bf16*)(ws + WS_MEMB) + (size_t)mm * DM, (float*)(ws + WS_SSQMEM) + (size_t)mm * 64, lane); }
    }
}

__device__ __forceinline__ void p_krn(ArgsP P, int l) {
    const int tid = local_tid(), lane = tid & 63, wave = __builtin_amdgcn_readfirstlane(tid >> 6), gw = blockIdx.x * NWAVES + wave, NGW = gridDim.x * NWAVES;
    unsigned char* ws = P->ws; const float* KR = (const float*)(ws + WS_KR); const int* pos = (const int*)P->in[2];
    const float gkr = (P->in[10] + l * QKD)[128 + lane], inv_freq = inv_freq_of(lane & 31);
    for (int row = gw; row < T; row += NGW) {
        float sn, cs; rope_sincos(pos[row], inv_freq, sn, cs);
        const float v = KR[(size_t)row * 64 + lane]; const float ss = wave_sum(v * v); const float r = v * rsqrtf(ss * (1.0f / 64.0f) + 1e-6f) * gkr; const float pr = __shfl_xor(r, 32);
        const float krv = (lane < 32) ? r * cs - pr * sn : pr * sn + r * cs;
        ((bf16*)(ws + WS_KRN))[(size_t)row * 64 + lane] = (unsigned short)f2bf(krv);
    }
}
#ifndef DBL_MASK
#define DBL_MASK 0
#endif
#define REP(k) for (int rep_ = 0; rep_ < 1 + (((DBL_MASK) >> (k)) & 1); ++rep_)
#ifndef PH_MASK
#define PH_MASK 0xFFF
#endif
#define EN(k) (((PH_MASK) >> (k)) & 1)
__global__ void __launch_bounds__(NWAVES * 64, 2) fwd(Args args) {
    extern __shared__ __attribute__((aligned(16))) unsigned char lds_raw[];
    LAS unsigned char* lds = (LAS unsigned char*)lds_raw;
    volatile LAS unsigned* MISC = (volatile LAS unsigned*)(lds + MISC_OFF);
    const int tid = threadIdx.x, G = gridDim.x;
    for (int u = tid; u < (LDS_BYTES - LDSCTL_OFF) / 4; u += NWAVES * 64) ((LAS unsigned*)(lds + LDSCTL_OFF))[u] = 0u;
    __syncthreads();
    XcdBarrier bar;
    { gu32* ctl = (gu32*)(args.ws + WS_CTL); bar.bar = (unsigned*)(ctl + CW_BAR); bar.x = 0; bar.st = nullptr;
      if (!MK_PER_PHASE) bar = xcd_barrier_post((unsigned*)(ctl + CW_BAR), MISC + 8); }
#define GRID_BAR() do { if (MK_PER_PHASE) { if (tid == 0) __hip_atomic_store((gu32*)bar.bar, 0xBADBA0u, RLX_AGENT); } else { xcd_barrier(bar); } } while (0)
    const int lo = args.ph_lo, hi = args.ph_hi;
#define IN(k) (lo <= (k) && (k) < hi)
#define BOTH(k) (IN(k) && IN((k) + 1))
#define SSQX(j) ((float*)(ws + WS_SSQX) + (size_t)(l * 3 + (j)) * T * 64)

    if (EN(0) && IN(0)) { REP(0) { p0_prologue(phase_args(), lds); __syncthreads(); } if (BOTH(0)) GRID_BAR(); }

    for (int l = 0; l < DEPTH; ++l) {
        const int pb = 1 + l * NPH;
        if (EN(1) && IN(pb + 0)) {
            const int nseg1 = (l == 0) ? 4 : 1, slot1 = (l == 0) ? (int)((blockIdx.x >> 3) & 3u) : -1;
            for (int seg = 0; seg < nseg1; ++seg) {
              if (seg == slot1) { conv_items(phase_args(), lds, I_IN, I_XKV0, I_XKV0 + I_XKV, I_LAYER - I_DN); __syncthreads(); }
              ArgsP A = phase_args(); unsigned char* ws = A->ws; unsigned char* wl = ws + WS_W + (size_t)l * WL_BYTES;
              pg8::Gemm g{(const bf16*)(ws + WS_XB), (const bf16*)(wl + WL_IN), T, IN_PAD, DM}; pg8::StaticOrder S; S.init(T, IN_PAD, G, (int)blockIdx.x); if (l == 0) { S.i0 = seg; S.i1 = seg + 1; }
              pg8::EpiInProj E{SSQX(0), (bf16*)(ws + WS_CQ), (bf16*)(ws + WS_CKV), (bf16*)(ws + WS_QSB), (bf16*)(ws + WS_KSB), (bf16*)(ws + WS_VSB), (float*)(ws + WS_KR), (float*)(ws + WS_SSQCQ) + (size_t)l * T * 16, (float*)(ws + WS_SSQCKV) + (size_t)l * T * 8, lds + RCACHE_OFF, 1 + 64 * (2 * l)};
              pg8::gemm_phase<pg8::EpiInProj, pg8::StaticOrder, true, true>(lds + RING_OFF, g, S, E); }
            { ArgsP A = phase_args(); unsigned char* ws = A->ws; unsigned char* wl = ws + WS_W + (size_t)l * WL_BYTES;
              pg8::Gemm g{(const bf16*)(ws + WS_MEMB), (const bf16*)(wl + WL_XKV), TMEM, 1024, DM}; pg8::StaticOrder S; S.init(TMEM, 1024, G, G == 256 ? (int)((blockIdx.x + 32u) & 255u) : (int)blockIdx.x);
              pg8::EpiScaleBf16<64> E{(const float*)(ws + WS_SSQMEM), 1.0f / 4096.0f, (bf16*)(ws + WS_KVX) + (size_t)l * TMEM * 1024, 1024};
              pg8::gemm_phase<pg8::EpiScaleBf16<64>, pg8::StaticOrder, true, true>(lds + RING_OFF, g, S, E); }
            if (BOTH(pb + 0)) GRID_BAR();
        }
        if (EN(2) && IN(pb + 1)) {
            { ArgsP A = phase_args(); unsigned char* ws = A->ws; unsigned char* wl = ws + WS_W + (size_t)l * WL_BYTES;
              pg8::Gemm g{(const bf16*)(ws + WS_CQ), (const bf16*)(wl + WL_QUP), T, QUP_N, QRANK}; pg8::StaticOrder S; S.init(T, QUP_N, G, (int)blockIdx.x);
              pg8::EpiScaleBf16<16> E{(const float*)(ws + WS_SSQCQ) + (size_t)l * T * 16, 1.0f / 1024.0f, (bf16*)(ws + WS_QRAW), QUP_N};
              pg8::gemm_phase<pg8::EpiScaleBf16<16>, pg8::StaticOrder, true, true>(lds + RING_OFF, g, S, E); }
            { ArgsP A = phase_args(); unsigned char* ws = A->ws; unsigned char* wl = ws + WS_W + (size_t)l * WL_BYTES;
              pg8::Gemm g{(const bf16*)(ws + WS_CKV), (const bf16*)(wl + WL_KVUP), T, KVUP_N, KVRANK}; pg8::StaticOrder S; S.init(T, KVUP_N, G, (int)blockIdx.x);
              pg8::EpiKvUp E{(const float*)(ws + WS_SSQCKV) + (size_t)l * T * 8, (bf16*)(ws + WS_KVRAW), A->in[10] + l * QKD, (LAS float*)(lds + XCH_OFF)};
              pg8::gemm_phase<pg8::EpiKvUp, pg8::StaticOrder, true, true>(lds + RING_OFF, g, S, E); }
            p_krn(phase_args(), l);
            if (BOTH(pb + 1)) GRID_BAR();
        }
        if (EN(4) && IN(pb + 3)) { REP(4) { p_attn_mfma(phase_args(), l, lds); } if (BOTH(pb + 3)) GRID_BAR(); }
        if (EN(6) && IN(pb + 5)) {
            ArgsP A = phase_args(); unsigned char* ws = A->ws; unsigned char* wl = ws + WS_W + (size_t)l * WL_BYTES; float* out = A->out;
            pg8::Gemm g{(const bf16*)(ws + WS_MIXED), (const bf16*)(wl + WL_OUT), T, DM, DM / 2, DM}; pg8::StaticOrder S; S.init(T, DM, G, (int)blockIdx.x); S.ksplit = 1;
            pg8::EpiResidual2 E{(bf16*)(ws + WS_XB), SSQX(1), (const float*)(ws + WS_SSQO)};
            pg8::gemm_phase<pg8::EpiResidual2, pg8::StaticOrder, true, true>(lds + RING_OFF, g, S, E);
            if (BOTH(pb + 5)) GRID_BAR();
        }
        if (EN(7) && IN(pb + 6)) {
            ArgsP A = phase_args(); unsigned char* ws = A->ws; unsigned char* wl = ws + WS_W + (size_t)l * WL_BYTES;
            pg8::Gemm g{(const bf16*)(ws + WS_XB), (const bf16*)(wl + WL_XQ), T, XW, DM / 4, DM}; pg8::SplitKOrder S; S.init(T, XW, 4, G, (int)blockIdx.x);
            pg8::EpiPartialBf16 E{(bf16*)(ws + WS_QX), XW, (size_t)T * XW};
            pg8::gemm_phase<pg8::EpiPartialBf16, pg8::SplitKOrder, true, true>(lds + RING_OFF, g, S, E);
            if (BOTH(pb + 6)) GRID_BAR();
        }
        if (EN(8) && IN(pb + 7)) { REP(8) p_xattn_mfma(phase_args(), l, lds); if (BOTH(pb + 7)) GRID_BAR(); }
        if (EN(9) && IN(pb + 8)) {
            ArgsP A = phase_args(); unsigned char* ws = A->ws; unsigned char* wl = ws + WS_W + (size_t)l * WL_BYTES; float* out = A->out;
            pg8::Gemm g{(const bf16*)(ws + WS_OX), (const bf16*)(wl + WL_XO), T, DM, XW}; pg8::StaticOrder S; S.init(T, DM, G, (int)blockIdx.x);
            pg8::EpiResidual E{nullptr, (bf16*)(ws + WS_XB), SSQX(2)};
            pg8::gemm_phase<pg8::EpiResidual, pg8::StaticOrder, true, true>(lds + RING_OFF, g, S, E);
            if (BOTH(pb + 8)) GRID_BAR();
        }
        if (EN(10) && IN(pb + 9)) {
            const int nseg10 = (l == 0) ? 8 : 1, slot10 = (l == 0) ? ((G == 256 && blockIdx.x >= 192) ? 8 : (int)((blockIdx.x >> 3) & 7u)) : -1;
            for (int seg = 0; seg <= nseg10; ++seg) {
              if (seg == slot10) { conv_items(phase_args(), lds, I_LAYER - I_DN, 2 * I_LAYER, 0, 0); __syncthreads(); }
              if (seg < nseg10) {
                ArgsP A = phase_args(); unsigned char* ws = A->ws; unsigned char* wl = ws + WS_W + (size_t)l * WL_BYTES;
                pg8::Gemm g{(const bf16*)(ws + WS_XB), (const bf16*)(wl + WL_GU), T, 2 * FF, DM}; pg8::StaticOrder S; S.init(T, 2 * FF, G, (int)blockIdx.x); if (l == 0) { S.i0 = seg; S.i1 = seg == 7 ? (1 << 28) : seg + 1; }
                pg8::EpiSwiGLU E{SSQX(2), (bf16*)(ws + WS_ACT), FF, lds + RCACHE_OFF, 1 + 64 * (2 * l + 1)};
                pg8::gemm_phase<pg8::EpiSwiGLU, pg8::StaticOrder, true, true>(lds + RING_OFF, g, S, E); } }
            if (BOTH(pb + 9)) GRID_BAR();
        }
        if (EN(11) && IN(pb + 10)) {
            ArgsP A = phase_args(); unsigned char* ws = A->ws; unsigned char* wl = ws + WS_W + (size_t)l * WL_BYTES; float* out = A->out;
            pg8::Gemm g{(const bf16*)(ws + WS_ACT), (const bf16*)(wl + WL_DN), T, DM, FF}; pg8::StaticOrder S; S.init(T, DM, G, (int)blockIdx.x);
            pg8::EpiResidual E{l == DEPTH - 1 ? out : nullptr, (bf16*)(ws + WS_XB), SSQX(3)};
            pg8::gemm_phase<pg8::EpiResidual, pg8::StaticOrder, true, true>(lds + RING_OFF, g, S, E);
            if (BOTH(pb + 10)) GRID_BAR();
        }
    }
#undef IN
#undef BOTH
}

extern "C" void kernel_launch(void* const* d_in, const int* in_sizes, int n_in, void* d_out, int out_size, void* d_ws, size_t ws_size, hipStream_t stream) {
    static int grid = 0;
    if (grid == 0) {
        if (n_in != 25 || in_sizes[0] != T * DM || out_size != T * DM || ws_size < WS_END) { fprintf(stderr, "kernel_launch: unexpected shapes (n_in %d, in0 %d, out %d, ws %zu < %zu); nothing launched\n", n_in, n_in > 0 ? in_sizes[0] : -1, out_size, ws_size, (size_t)WS_END); grid = -1; return; }
        int dev = 0, cus = 0, per_cu = 0;
        if (hipGetDevice(&dev) != hipSuccess || hipDeviceGetAttribute(&cus, hipDeviceAttributeMultiprocessorCount, dev) != hipSuccess) { grid = -1; return; }
        if (hipFuncSetAttribute((const void*)fwd, hipFuncAttributeMaxDynamicSharedMemorySize, LDS_BYTES) != hipSuccess) { fprintf(stderr, "kernel_launch: hipFuncSetAttribute failed\n"); grid = -1; return; }
        if (hipOccupancyMaxActiveBlocksPerMultiprocessor(&per_cu, (const void*)fwd, NWAVES * 64, LDS_BYTES) != hipSuccess || per_cu < 1) { fprintf(stderr, "kernel_launch: occupancy query reports %d\n", per_cu); }
        (void)hipGetLastError();
        grid = cus;
    }
    if (grid < 0) return;
    if (hipMemsetAsync((char*)d_ws + WS_CTL, 0, CTL_ZERO_BYTES, stream) != hipSuccess) { fprintf(stderr, "kernel_launch: memset failed\n"); return; }
    Args a{};
    for (int i = 0; i < 25; ++i) a.in[i] = (const float*)d_in[i];
    a.out = (float*)d_out; a.ws = (unsigned char*)d_ws; a.pad = 0;
#if MK_PER_PHASE
    for (int p = 0; p < N_PHASES; ++p) { a.ph_lo = p; a.ph_hi = p + 1; a.li = p; hipLaunchKernelGGL(fwd, dim3(grid), dim3(NWAVES * 64), LDS_BYTES, stream, a); }
#else
    a.ph_lo = 0; a.ph_hi = N_PHASES; a.li = 0;
    hipLaunchKernelGGL(fwd, dim3(grid), dim3(NWAVES * 64), LDS_BYTES, stream, a);
#endif
    const hipError_t le = hipPeekAtLastError();
    if (le != hipSuccess) fprintf(stderr, "kernel_launch: launch failed: %s\n", hipGetErrorName(le));
}
```
